# Optimizing an MI355X kernel written in HIP

```python
import jax, jax.numpy as jnp
from jax import lax
import numpy as np

D_MODEL = 2048
BATCH = 8
SEQ = 4096
DEPTH = 2

GRID_W = 64
CTX_LEN = 256
EPS = 1e-6
NEG_INF = -1e30
N_BRANCH = 4
BR_W = D_MODEL // 4
CONV_W = 31
CONV_PAD = (CONV_W - 1) // 2
LRU_BLOCKS = 8
LRU_BLOCK_W = BR_W // LRU_BLOCKS
SHORT_CONV_W = 4
SHORT_CONV_PAD = (2, 1)
LRU_C = 8.0
HEAD_DIM = 64
N_Q_HEADS = BR_W // HEAD_DIM
N_KV_HEADS = 2
Q_W = N_Q_HEADS * HEAD_DIM
KV_W = N_KV_HEADS * HEAD_DIM
WINDOW = 128
Q_BLOCK = 128
ROPE_THETA = 10000.0
POOL_WINDOWS = (2, 4, 8, 16)
N_POOL = len(POOL_WINDOWS)
POOL_GROUP_W = BR_W // N_POOL
N_EXPERTS = 16
N_GROUPS = 4
EXPERTS_PER_GROUP = N_EXPERTS // N_GROUPS
TOP_K = 2
D_EXPERT = D_MODEL // 2
MOE_BLOCK = 256
IN_SPLITS = (BR_W, BR_W, BR_W, BR_W, Q_W, KV_W, KV_W, BR_W)
IN_OFFSETS = tuple(int(o) for o in np.cumsum(IN_SPLITS)[:-1])
IN_COLS = int(sum(IN_SPLITS))
OFF_RX = IN_OFFSETS[1]
OFF_K = IN_OFFSETS[4]
OFF_V_END = IN_OFFSETS[6]

kernel_name = 'hybrid_parallel_mixers_grouped_moe_dit'


def rmsnorm(x, g):
    xf = x.astype(jnp.float32)
    r = lax.rsqrt(jnp.mean(xf * xf, axis=-1, keepdims=True) + EPS)
    return (xf * r).astype(x.dtype) * g


def layernorm(x, g, b):
    xf = x.astype(jnp.float32)
    mu = jnp.mean(xf, axis=-1, keepdims=True)
    var = jnp.mean(jnp.square(xf - mu), axis=-1, keepdims=True)
    return ((xf - mu) * lax.rsqrt(var + EPS)).astype(x.dtype) * g + b


def modulate(x, g, shift, scale):
    return rmsnorm(x, g) * (1.0 + scale) + shift


def depthwise_conv(x, w, b, pad):
    y = lax.conv_general_dilated(x, w[:, None, :], window_strides=(1,), padding=(pad,),
                                 dimension_numbers=('NWC', 'WIO', 'NWC'),
                                 feature_group_count=x.shape[-1])
    return y + b


def axial_rope(n_tokens):
    rows = n_tokens // GRID_W
    row = jnp.repeat(jnp.arange(rows, dtype=jnp.float32), GRID_W)
    col = jnp.tile(jnp.arange(GRID_W, dtype=jnp.float32), rows)
    n_freq = HEAD_DIM // 4
    inv = ROPE_THETA ** (-jnp.arange(n_freq, dtype=jnp.float32) / n_freq)
    ang = jnp.concatenate([row[:, None] * inv, col[:, None] * inv], axis=-1)
    return jnp.cos(ang), jnp.sin(ang)


def apply_rope(x, cos, sin):
    shp = (1, cos.shape[0]) + (1,) * (x.ndim - 3) + (cos.shape[1],)
    c, s = cos.reshape(shp), sin.reshape(shp)
    x1, x2 = jnp.split(x.astype(jnp.float32), 2, axis=-1)
    return jnp.concatenate([x1 * c - x2 * s, x1 * s + x2 * c], axis=-1).astype(x.dtype)


def conformer_conv(u, g, w, b, ln_g, ln_b):
    y = u * jax.nn.sigmoid(g)
    y = depthwise_conv(y, w, b, (CONV_PAD, CONV_PAD))
    return jax.nn.silu(layernorm(y, ln_g, ln_b))


def rglru_coeffs(x, w_a, b_a, w_x, b_x, lam):
    xb = x.reshape(x.shape[:-1] + (LRU_BLOCKS, LRU_BLOCK_W))
    gate_a = jnp.einsum('blhi,hij->blhj', xb, w_a).reshape(x.shape) + b_a
    gate_x = jnp.einsum('blhi,hij->blhj', xb, w_x).reshape(x.shape) + b_x
    r = jax.nn.sigmoid(gate_a.astype(jnp.float32))
    i = jax.nn.sigmoid(gate_x.astype(jnp.float32))
    log_a = -LRU_C * r * jax.nn.softplus(-lam.astype(jnp.float32))
    a = jnp.exp(log_a)
    b = jnp.sqrt(-jnp.expm1(2.0 * log_a)) * i * x.astype(jnp.float32)
    return a, b


def _affine_combine(left, right):
    a_l, b_l = left
    a_r, b_r = right
    return a_l * a_r, a_r * b_l + b_r


def linear_scan(a, b, h0, reverse):
    if h0 is not None:
        first = -1 if reverse else 0
        b = b.at[:, first].add(a[:, first] * h0)
    _, h = lax.associative_scan(_affine_combine, (a, b), axis=1, reverse=reverse)
    return h


def rglru_branch(x_lat, g_lat, x_ctx, g_ctx, conv_w, conv_b, w_a, b_a, w_x, b_x, lam):
    x_lat = depthwise_conv(x_lat, conv_w, conv_b, SHORT_CONV_PAD)
    x_ctx = depthwise_conv(x_ctx, conv_w, conv_b, SHORT_CONV_PAD)
    h_lat = 0.0
    h_ctx = 0.0
    for d, rev in enumerate((False, True)):
        a_c, b_c = rglru_coeffs(x_ctx, w_a[d], b_a[d], w_x[d], b_x[d], lam[d])
        hc_d = linear_scan(a_c, b_c, None, rev)
        h_end = hc_d[:, 0] if rev else hc_d[:, -1]
        a_l, b_l = rglru_coeffs(x_lat, w_a[d], b_a[d], w_x[d], b_x[d], lam[d])
        h_lat = h_lat + linear_scan(a_l, b_l, h_end, rev)
        if g_ctx is not None:
            h_ctx = h_ctx + hc_d
    y_lat = (h_lat * jax.nn.gelu(g_lat.astype(jnp.float32))).astype(x_lat.dtype)
    if g_ctx is None:
        return y_lat, None
    y_ctx = (h_ctx * jax.nn.gelu(g_ctx.astype(jnp.float32))).astype(x_ctx.dtype)
    return y_lat, y_ctx


def attend_with_sink(s, v, sink):
    sk = sink[None, :, :, None, None]
    m = jnp.maximum(jnp.max(s, axis=-1, keepdims=True), sk)
    p = jnp.exp(s - m)
    p = p / (jnp.sum(p, axis=-1, keepdims=True) + jnp.exp(sk - m))
    return jnp.einsum('bkgqs,bskd->bqkgd', p.astype(v.dtype), v)


def window_attention(q, k, v, cq, ck, cv, q_norm_g, k_norm_g, attn_sink, cos, sin):
    B, S, _ = q.shape
    C = ck.shape[1]
    G = N_Q_HEADS // N_KV_HEADS
    scale = HEAD_DIM ** -0.5
    q = apply_rope(rmsnorm(q.reshape(B, S, N_KV_HEADS, G, HEAD_DIM), q_norm_g), cos, sin)
    k = apply_rope(rmsnorm(k.reshape(B, S, N_KV_HEADS, HEAD_DIM), k_norm_g), cos, sin)
    v = v.reshape(B, S, N_KV_HEADS, HEAD_DIM)
    ck = rmsnorm(ck.reshape(B, C, N_KV_HEADS, HEAD_DIM), k_norm_g)
    cv = cv.reshape(B, C, N_KV_HEADS, HEAD_DIM)
    sink = attn_sink.reshape(N_KV_HEADS, G).astype(jnp.float32)
    n_blk = S // Q_BLOCK
    span = Q_BLOCK + 2 * WINDOW
    kp = jnp.pad(k, ((0, 0), (WINDOW, WINDOW), (0, 0), (0, 0)))
    vp = jnp.pad(v, ((0, 0), (WINDOW, WINDOW), (0, 0), (0, 0)))
    qb = jnp.moveaxis(q.reshape(B, n_blk, Q_BLOCK, N_KV_HEADS, G, HEAD_DIM), 1, 0)
    rel = jnp.arange(span)[None, :] - WINDOW - jnp.arange(Q_BLOCK)[:, None]
    in_window = jnp.abs(rel) <= WINDOW

    def block(args):
        qi, i = args
        start = i * Q_BLOCK
        ki = lax.dynamic_slice_in_dim(kp, start, span, axis=1)
        vi = lax.dynamic_slice_in_dim(vp, start, span, axis=1)
        key_pos = start - WINDOW + jnp.arange(span)
        valid = in_window & ((key_pos >= 0) & (key_pos < S))[None, :]
        s_lat = jnp.einsum('bqkgd,bskd->bkgqs', qi, ki, preferred_element_type=jnp.float32) * scale
        s_lat = jnp.where(valid, s_lat, NEG_INF)
        s_ctx = jnp.einsum('bqkgd,bckd->bkgqc', qi, ck, preferred_element_type=jnp.float32) * scale
        return attend_with_sink(jnp.concatenate([s_lat, s_ctx], axis=-1),
                                jnp.concatenate([vi, cv], axis=1), sink)

    y = lax.map(block, (qb, jnp.arange(n_blk)))
    y = jnp.moveaxis(y, 0, 1).reshape(B, S, Q_W)
    if cq is None:
        return y, None
    cq = rmsnorm(cq.reshape(B, C, N_KV_HEADS, G, HEAD_DIM), q_norm_g)
    s = jnp.einsum('bqkgd,bskd->bkgqs', cq, ck, preferred_element_type=jnp.float32) * scale
    yc = attend_with_sink(s, cv, sink).reshape(B, C, Q_W)
    return y, yc


def pool_mixer(u, pool_w, pool_scale):
    B, L, _ = u.shape
    uf = u.astype(jnp.float32)
    cs = jnp.pad(jnp.cumsum(uf, axis=1), ((0, 0), (1, 0), (0, 0)))
    t = jnp.arange(L)
    groups = []
    for gi, w in enumerate(POOL_WINDOWS):
        lo = jnp.clip(t - w // 2, 0, L)
        hi = jnp.clip(t + w - w // 2, 0, L)
        sl = slice(gi * POOL_GROUP_W, (gi + 1) * POOL_GROUP_W)
        csg = cs[..., sl]
        cnt = (hi - lo).astype(jnp.float32)[None, :, None]
        mean = (jnp.take(csg, hi, axis=1) - jnp.take(csg, lo, axis=1)) / cnt
        groups.append(mean - uf[..., sl])
    y = jnp.stack(groups, axis=2).astype(u.dtype)
    y = jnp.einsum('blgi,gij->blgj', y, pool_w).reshape(B, L, BR_W)
    return y * pool_scale


def merge_branches(h, branches, w_branch, w_gate, b_gate, w_out):
    acc = 0.0
    for kb, br in enumerate(branches):
        gate = jax.nn.sigmoid(h @ w_gate[kb] + b_gate[kb])
        acc = acc + gate * (br @ w_branch[kb])
    return acc @ w_out


def token_mixer(h, hc, w_in, conv_w, conv_b, conv_ln_g, conv_ln_b, lru_conv_w, lru_conv_b,
                lru_w_a, lru_b_a, lru_w_x, lru_b_x, lru_lambda, q_norm_g, k_norm_g, attn_sink,
                pool_w, pool_scale, w_branch, w_gate, b_gate, w_out, cos, sin, ctx_out):
    a_u, a_g, r_x, r_g, q, k, v, p_in = jnp.split(h @ w_in, IN_OFFSETS, axis=-1)
    if ctx_out:
        ca_u, ca_g, cr_x, cr_g, cq, ck, cv, cp_in = jnp.split(hc @ w_in, IN_OFFSETS, axis=-1)
    else:
        cr_x = hc @ w_in[:, OFF_RX:OFF_RX + BR_W]
        ck, cv = jnp.split(hc @ w_in[:, OFF_K:OFF_V_END], 2, axis=-1)
        cr_g = None
        cq = None
    br_a = conformer_conv(a_u, a_g, conv_w, conv_b, conv_ln_g, conv_ln_b)
    br_b, cbr_b = rglru_branch(r_x, r_g, cr_x, cr_g, lru_conv_w, lru_conv_b,
                               lru_w_a, lru_b_a, lru_w_x, lru_b_x, lru_lambda)
    br_c, cbr_c = window_attention(q, k, v, cq, ck, cv, q_norm_g, k_norm_g, attn_sink, cos, sin)
    br_d = pool_mixer(p_in, pool_w, pool_scale)
    y = merge_branches(h, (br_a, br_b, br_c, br_d), w_branch, w_gate, b_gate, w_out)
    if not ctx_out:
        return y, None
    cbr_a = conformer_conv(ca_u, ca_g, conv_w, conv_b, conv_ln_g, conv_ln_b)
    cbr_d = pool_mixer(cp_in, pool_w, pool_scale)
    yc = merge_branches(hc, (cbr_a, cbr_b, cbr_c, cbr_d), w_branch, w_gate, b_gate, w_out)
    return y, yc


def moe_ffn(h, w_router, router_bias, w_g, w_u, w_d):
    shp = h.shape
    xt = h.reshape(-1, shp[-1])
    T = xt.shape[0]
    score = jax.nn.sigmoid(jnp.matmul(xt, w_router, preferred_element_type=jnp.float32))
    sel = (score + router_bias.astype(jnp.float32)).reshape(T, N_GROUPS, EXPERTS_PER_GROUP)
    group_score = lax.top_k(sel, TOP_K)[0].sum(axis=-1)
    best = jnp.argmax(group_score, axis=-1)
    in_group = (jnp.arange(N_GROUPS)[None, :] == best[:, None])[..., None]
    masked = jnp.where(in_group, sel, -jnp.inf).reshape(T, N_EXPERTS)
    _, top_e = lax.top_k(masked, TOP_K)
    top_s = jnp.take_along_axis(score, top_e, axis=-1)
    top_w = top_s / jnp.sum(top_s, axis=-1, keepdims=True)
    A = T * TOP_K
    flat_e = top_e.reshape(A)
    order = jnp.argsort(flat_e)
    e_sorted = flat_e[order]
    tok_sorted = (order // TOP_K).astype(jnp.int32)
    w_sorted = top_w.reshape(A)[order]
    counts = jnp.bincount(flat_e, length=N_EXPERTS)
    padded = (counts + MOE_BLOCK - 1) // MOE_BLOCK * MOE_BLOCK
    pad_end = jnp.cumsum(padded)
    start = jnp.cumsum(counts) - counts
    dest = (pad_end - padded)[e_sorted] + jnp.arange(A) - start[e_sorted]
    n_blk = (A + MOE_BLOCK - 1) // MOE_BLOCK + N_EXPERTS
    R = n_blk * MOE_BLOCK
    row_tok = jnp.full((R,), T, jnp.int32).at[dest].set(tok_sorted)
    row_w = jnp.zeros((R,), jnp.float32).at[dest].set(w_sorted)
    block_e = jnp.minimum(jnp.searchsorted(pad_end, jnp.arange(n_blk) * MOE_BLOCK, side='right'),
                          N_EXPERTS - 1)
    x_pad = jnp.concatenate([xt, jnp.zeros((1, shp[-1]), xt.dtype)], axis=0)

    def run_block(args):
        tok, e = args
        xb = x_pad[tok]
        hb = jax.nn.silu(xb @ w_g[e]) * (xb @ w_u[e])
        return hb @ w_d[e]

    out = lax.map(run_block, (row_tok.reshape(n_blk, MOE_BLOCK), block_e))
    out = out.reshape(R, shp[-1]) * row_w[:, None].astype(out.dtype)
    y = jnp.zeros_like(x_pad).at[row_tok].add(out)[:T]
    return y.reshape(shp)


def setup_inputs(seed: int = 0) -> dict:
    key = jax.random.key(seed)
    keys = iter(jax.random.split(key, 64))

    def nrm(shape, scale):
        return jax.random.normal(next(keys), shape, jnp.float32) * scale

    L, D = DEPTH, D_MODEL
    lam_a = jax.random.uniform(next(keys), (L, 2, BR_W), jnp.float32, 0.9, 0.999) ** (1.0 / LRU_C)
    return {
        'x': nrm((BATCH, SEQ, D), 1.0),
        'c': nrm((BATCH, D), 1.0),
        'ctx': nrm((BATCH, CTX_LEN, D), 1.0),
        'c_ctx': nrm((D,), 1.0),
        'w_ada': nrm((L, D, 6 * D), 0.5 * D ** -0.5),
        'b_ada': nrm((L, 6 * D), 0.02),
        'norm_mix_g': 1.0 + nrm((L, D), 0.05),
        'norm_ffn_g': 1.0 + nrm((L, D), 0.05),
        'w_in': nrm((L, D, IN_COLS), D ** -0.5),
        'conv_w': nrm((L, CONV_W, BR_W), CONV_W ** -0.5),
        'conv_b': nrm((L, BR_W), 0.02),
        'conv_ln_g': 1.0 + nrm((L, BR_W), 0.05),
        'conv_ln_b': nrm((L, BR_W), 0.02),
        'lru_conv_w': nrm((L, SHORT_CONV_W, BR_W), SHORT_CONV_W ** -0.5),
        'lru_conv_b': nrm((L, BR_W), 0.02),
        'lru_w_a': nrm((L, 2, LRU_BLOCKS, LRU_BLOCK_W, LRU_BLOCK_W), LRU_BLOCK_W ** -0.5),
        'lru_b_a': nrm((L, 2, BR_W), 0.02),
        'lru_w_x': nrm((L, 2, LRU_BLOCKS, LRU_BLOCK_W, LRU_BLOCK_W), LRU_BLOCK_W ** -0.5),
        'lru_b_x': nrm((L, 2, BR_W), 0.02),
        'lru_lambda': jnp.log(lam_a) - jnp.log1p(-lam_a),
        'q_norm_g': 1.0 + nrm((L, HEAD_DIM), 0.05),
        'k_norm_g': 1.0 + nrm((L, HEAD_DIM), 0.05),
        'attn_sink': nrm((L, N_Q_HEADS), 0.5),
        'pool_w': nrm((L, N_POOL, POOL_GROUP_W, POOL_GROUP_W), POOL_GROUP_W ** -0.5),
        'pool_scale': 1.0 + nrm((L, BR_W), 0.05),
        'w_branch': nrm((L, N_BRANCH, BR_W, D), BR_W ** -0.5),
        'w_gate': nrm((L, N_BRANCH, D, D), D ** -0.5),
        'b_gate': nrm((L, N_BRANCH, D), 0.02),
        'w_out': nrm((L, D, D), D ** -0.5),
        'w_router': nrm((D, N_EXPERTS), D ** -0.5),
        'router_bias': nrm((N_EXPERTS,), 0.01),
        'exp_w_gate': nrm((L, N_EXPERTS, D, D_EXPERT), D ** -0.5),
        'exp_w_up': nrm((L, N_EXPERTS, D, D_EXPERT), D ** -0.5),
        'exp_w_down': nrm((L, N_EXPERTS, D_EXPERT, D), D_EXPERT ** -0.5),
    }


def reference(x, c, ctx, c_ctx, w_ada, b_ada, norm_mix_g, norm_ffn_g, w_in, conv_w, conv_b,
              conv_ln_g, conv_ln_b, lru_conv_w, lru_conv_b, lru_w_a, lru_b_a, lru_w_x, lru_b_x,
              lru_lambda, q_norm_g, k_norm_g, attn_sink, pool_w, pool_scale, w_branch, w_gate,
              b_gate, w_out, w_router, router_bias, exp_w_gate, exp_w_up, exp_w_down):
    cos, sin = axial_rope(x.shape[1])
    for l in range(DEPTH):
        ctx_out = l < DEPTH - 1
        mod = jax.nn.silu(c) @ w_ada[l] + b_ada[l]
        sh1, sc1, g1, sh2, sc2, g2 = [m[:, None, :] for m in jnp.split(mod, 6, axis=-1)]
        mod_c = jax.nn.silu(c_ctx) @ w_ada[l] + b_ada[l]
        csh1, csc1, cg1, csh2, csc2, cg2 = jnp.split(mod_c, 6)
        h = modulate(x, norm_mix_g[l], sh1, sc1)
        hc = modulate(ctx, norm_mix_g[l], csh1, csc1)
        y, yc = token_mixer(h, hc, w_in[l], conv_w[l], conv_b[l], conv_ln_g[l], conv_ln_b[l],
                            lru_conv_w[l], lru_conv_b[l], lru_w_a[l], lru_b_a[l], lru_w_x[l],
                            lru_b_x[l], lru_lambda[l], q_norm_g[l], k_norm_g[l], attn_sink[l],
                            pool_w[l], pool_scale[l], w_branch[l], w_gate[l], b_gate[l], w_out[l],
                            cos, sin, ctx_out)
        x = x + g1 * y
        h2 = modulate(x, norm_ffn_g[l], sh2, sc2)
        x = x + g2 * moe_ffn(h2, w_router, router_bias, exp_w_gate[l], exp_w_up[l], exp_w_down[l])
        if ctx_out:
            ctx = ctx + cg1 * yc
            hc2 = modulate(ctx, norm_ffn_g[l], csh2, csc2)
            ctx = ctx + cg2 * moe_ffn(hc2, w_router, router_bias, exp_w_gate[l], exp_w_up[l], exp_w_down[l])
    return x
```

```cpp
#include <hip/hip_runtime.h>
#include <cstdio>
#include <cstdint>

#define DBG_DUMP 0
#define DBG_POOLY 0
#define DBG_BRSEL 1
#ifndef DBG_TWICE
#define DBG_TWICE 0
#endif
#ifndef GEMM_SIMPLE
#define GEMM_SIMPLE 0
#endif
#ifndef DBG_SAFE
#define DBG_SAFE 0
#endif
#ifndef DBG_PH_HI
#define DBG_PH_HI 20
#endif
#ifndef MK_PER_PHASE
#define MK_PER_PHASE 0
#endif

#define GAS __attribute__((address_space(1)))
#define LAS __attribute__((address_space(3)))
#define DI __device__ __forceinline__
typedef unsigned short bf16;
typedef unsigned v4u __attribute__((ext_vector_type(4)));
typedef unsigned v2u __attribute__((ext_vector_type(2)));
typedef float f32x4 __attribute__((ext_vector_type(4)));
typedef float f32x2 __attribute__((ext_vector_type(2)));
typedef short bf16x8 __attribute__((ext_vector_type(8)));

constexpr int D = 2048, NB = 8, SEQ = 4096, CTX = 256, DEPTH = 2;
constexpr int TL = NB * SEQ, TC = NB * CTX, MT = TL + TC;
constexpr int BRW = 512, INC = 3328, NGATE = 4 * D, N2 = INC + NGATE;
constexpr int NE = 16, DE = 1024, ECAP = MT;
constexpr int MAXTILES = 288;
constexpr float EPS = 1e-6f;
constexpr int U_RX = 0, U_K = 512, U_V = 640, U_AU = 768, U_AG = 1280, U_RG = 1792, U_Q = 2304, U_P = 2816;
constexpr int B_A = 0, B_B = 512, B_C = 1024, B_D = 1536;
constexpr int MO_SH1 = 0, MO_SC1 = 2048, MO_G1 = 4096, MO_SH2 = 6144, MO_SC2 = 8192, MO_G2 = 10240, MODW = 12288;

constexpr size_t MiB = 1u << 20;
constexpr size_t WS_CTL = 0, CTL_BYTES = 1 * MiB;
constexpr size_t WS_MOD = 1 * MiB;
constexpr size_t WS_LIST = 2 * MiB;
constexpr size_t LIST_ROW = 0, LIST_W = (size_t)NE * ECAP * 4, LIST_TS = 2 * (size_t)NE * ECAP * 4;
constexpr size_t WS_SMALLW = 7 * MiB;
constexpr size_t SW_LRU = 0, SW_POOL = 262144;
constexpr size_t WS_W2 = 8 * MiB;
constexpr size_t WS_WB = 53 * MiB;
constexpr size_t WS_WO = 61 * MiB;
constexpr size_t WS_WGU = 69 * MiB;
constexpr size_t WS_WD = 197 * MiB;
constexpr size_t WS_H = 261 * MiB;
constexpr size_t WS_U = 397 * MiB;
constexpr size_t WS_G = 618 * MiB;
constexpr size_t WS_HB = WS_G, WS_O = WS_G + 144 * MiB;
constexpr size_t WS_BR = 1162 * MiB;
constexpr size_t WS_XC = 1298 * MiB;
constexpr size_t WS_END = 1314 * MiB;
constexpr int CW_TMO = 0;
constexpr int CW_BAR = 4096;
constexpr int CW_CNT = 16384;
constexpr int CW_QUEUE = 20480;

constexpr int RING_BYTES = 131072;
constexpr int LDSCTL_OFF = RING_BYTES;
constexpr int LDS_BYTES = 147456;

DI float bf2f(unsigned b) { return __uint_as_float(b << 16); }
DI float bflo(unsigned w) { return __uint_as_float(w << 16); }
DI float bfhi(unsigned w) { return __uint_as_float(w & 0xffff0000u); }
DI unsigned f2bf(float f) { unsigned u = __float_as_uint(f); return (u + 0x7fffu + ((u >> 16) & 1u)) >> 16; }
DI unsigned pk2(float lo, float hi) { return f2bf(lo) | (f2bf(hi) << 16); }
DI float wave_sum(float v) {
#pragma unroll
    for (int o = 1; o < 64; o <<= 1) v += __shfl_xor(v, o);
    return v;
}
DI float wave_max(float v) {
#pragma unroll
    for (int o = 1; o < 64; o <<= 1) v = fmaxf(v, __shfl_xor(v, o));
    return v;
}
DI float sigmoidf_(float x) { return 1.0f / (1.0f + __expf(-x)); }
DI float siluf_(float x) { return x / (1.0f + __expf(-x)); }
DI float gelu_tanh(float x) { const float u = 0.7978845608028654f * (x + 0.044715f * x * x * x); const float e = __expf(2.0f * u); const float t = 1.0f - 2.0f / (e + 1.0f); return 0.5f * x * (1.0f + t); }
DI int lane_id_asm() { int l; asm volatile("v_mbcnt_lo_u32_b32 %0, -1, 0\n\tv_mbcnt_hi_u32_b32 %0, -1, %0" : "=v"(l)); return l; }
#define LDS_WAIT() asm volatile("s_waitcnt lgkmcnt(0)" ::: "memory")
#define VM_WAIT() asm volatile("s_waitcnt vmcnt(0)" ::: "memory")

#define XB_TMO      128
#define XB_XCNT(j)  (256  + 64 * (j))
#define XB_XSUB(j)  (1280 + 64 * (j))
#define XB_XGEN(j)  (2304 + 64 * (j))
#define XB_TOP      3328
#define XB_TOPGEN   3392
#define XCD_BAR_WORDS 3456
#define XB_SPIN_CAP (1u << 20)
DI unsigned xb_ld(unsigned* p)              { return __hip_atomic_load(p, __ATOMIC_RELAXED, __HIP_MEMORY_SCOPE_AGENT); }
DI unsigned xb_add(unsigned* p, unsigned v) { return __hip_atomic_fetch_add(p, v, __ATOMIC_RELAXED, __HIP_MEMORY_SCOPE_AGENT); }
DI unsigned xb_xcc_id() { return (unsigned)__builtin_amdgcn_s_getreg((3 << 11) | 20) & 0xFu; }
#define XB_SPIN(cond, bar) do { unsigned _sp = 0; while (cond) { __builtin_amdgcn_s_sleep(1); \
    if ((++_sp & 255u) == 0u) { if (xb_ld(&(bar)[XB_TMO])) break; if (_sp > XB_SPIN_CAP) { atomicAdd(&(bar)[XB_TMO], 1u); break; } } } } while (0)
struct XcdBarrier { unsigned* bar; unsigned x; volatile LAS unsigned* st; };
DI XcdBarrier xcd_barrier_post(unsigned* bar, volatile LAS unsigned* st) {
    XcdBarrier b; b.bar = bar; b.x = xb_xcc_id(); b.st = st;
    if (threadIdx.x == 0) (void)xb_add(&bar[XB_XCNT(b.x)], 1u);
    return b;
}
DI void xcd_barrier_complete(unsigned* bar, unsigned x, unsigned& nloc, unsigned& nx) {
    const unsigned G = gridDim.x * gridDim.y * gridDim.z;
    unsigned sum, cnt, mine, sp = 0u;
    for (;;) {
        sum = 0u; cnt = 0u; mine = 0u;
#pragma unroll
        for (unsigned j = 0; j < 16; ++j) { const unsigned c = xb_ld(&bar[XB_XCNT(j)]); sum += c; cnt += (c > 0u) ? 1u : 0u; mine = (j == x) ? c : mine; }
        if (sum == G) break;
        __builtin_amdgcn_s_sleep(1);
        if ((++sp & 255u) == 0u) { if (xb_ld(&bar[XB_TMO])) break; if (sp > XB_SPIN_CAP) { atomicAdd(&bar[XB_TMO], 1u); break; } }
    }
    nloc = mine > 0u ? mine : 1u; nx = cnt > 0u ? cnt : 1u;
}
DI void xcd_barrier(const XcdBarrier& b) {
    asm volatile("s_waitcnt vmcnt(0)" ::: "memory");
    __syncthreads();
    if (threadIdx.x == 0) {
        unsigned* bar = b.bar;
        __builtin_amdgcn_s_waitcnt(0);
        unsigned nloc = b.st[0], nx = b.st[1];
        if (nloc == 0u) { xcd_barrier_complete(bar, b.x, nloc, nx); b.st[0] = nloc; b.st[1] = nx; }
        const unsigned old = xb_add(&bar[XB_XSUB(b.x)], 1u);
        const unsigned gen = old / nloc;
        if (old + 1u == (gen + 1u) * nloc) {
            __builtin_amdgcn_fence(__ATOMIC_RELEASE, "agent");
            asm volatile("s_waitcnt vmcnt(0)" ::: "memory");
            const unsigned og = xb_add(&bar[XB_TOP], 1u);
            const unsigned tg = og / nx;
            if (og + 1u == (tg + 1u) * nx) xb_add(&bar[XB_TOPGEN], 1u);
            else XB_SPIN(xb_ld(&bar[XB_TOPGEN]) == tg, bar);
            __builtin_amdgcn_fence(__ATOMIC_ACQUIRE, "agent");
            xb_add(&bar[XB_XGEN(b.x)], 1u);
            asm volatile("s_waitcnt vmcnt(0)" ::: "memory");
        } else {
            XB_SPIN(xb_ld(&bar[XB_XGEN(b.x)]) == gen, bar);
            __builtin_amdgcn_fence(__ATOMIC_ACQUIRE, "agent");
            asm volatile("s_waitcnt vmcnt(0)" ::: "memory");
        }
    }
    __syncthreads();
}

namespace pg8 {
constexpr int BM = 256, BK = 64, HALF = 128, HTB = HALF * BK * 2, STAGE_BYTES = 8 * HTB, NXCD = 8, WGM = 8;
__host__ __device__ __forceinline__ int lds_byte(int r, int c) { const int st = (r >> 4) * 2 + (c >> 5), rr = r & 15, cc = c & 31, ob = rr * 64 + cc * 2; return st * 1024 + (ob ^ (((ob >> 9) & 1) << 5)); }
__host__ __device__ __forceinline__ void stage_rc(int b, int& R, int& C) { const int st = b / 1024, sb = b % 1024, swz = sb ^ (((sb >> 9) & 1) << 5); R = (st >> 1) * 16 + swz / 64; C = (st & 1) * 32 + (swz % 64) / 2; }
__host__ __device__ __forceinline__ int perm32(int rho) { const int n = rho >> 4, i = rho & 15; return 8 * (i >> 2) + 4 * n + (i & 3); }

struct Unit {
    const char* a;
    const char* b;
    const int* rows;
    int nvalid;
    int i0, i1, i2, i3;
};
DI void tile_of(int L, int nM, int nN, int& pm, int& pn) {
    const int nwg = nM * nN; int wgid = L;
    { const int q = nwg / NXCD, r = nwg % NXCD, xcd = wgid % NXCD, off = wgid / NXCD; wgid = (xcd < r ? xcd * (q + 1) : r * (q + 1) + (xcd - r) * q) + off; }
    const int nig = WGM * nN, gid = wgid / nig, fm = gid * WGM, gsz = (nM - fm) < WGM ? (nM - fm) : WGM;
    pm = fm + ((wgid % nig) % gsz); pn = (wgid % nig) / gsz;
}

template <class Epi, class Sched, bool GATHER>
DI void gemm_phase(LAS unsigned char* lds, const int wid, const int K, const unsigned lda, const unsigned ldb, const Sched& S, const Epi& E) {
    const int lane = lane_id_asm(), tid = wid * 64 + lane; const int wr = wid >> 2, wc = wid & 3, fr = lane & 15, fq = lane >> 4;
    const int nt = K / BK;
    unsigned voffA[2], voffB[2]; int RA[2], CA2[2];
#pragma unroll
    for (int i = 0; i < 2; ++i) { int R, C; stage_rc(tid * 16 + i * 8192, R, C); const int Rb = Epi::PERM ? ((R & ~31) + perm32(R & 31)) : R;
        RA[i] = R; CA2[i] = C * 2; voffA[i] = (unsigned)R * lda + (unsigned)C * 2u; voffB[i] = (unsigned)Rb * ldb + (unsigned)C * 2u; }
    const size_t kstep = (size_t)(BK * 2);
    const size_t hstepA = GATHER ? 0 : (size_t)HALF * lda, hstepB = (size_t)HALF * ldb;
    const unsigned ldsw = (unsigned)wid * 1024u;
    const int aoff = lds_byte(wr * 64 + fr, fq * 8), boff = lds_byte(wc * 32 + fr, fq * 8);
#define PG8_SA(b, h) (((b) * 2 + (h)) * HTB)
#define PG8_SB(b, h) ((4 + (b) * 2 + (h)) * HTB)
#define PG8_GL(bufoff, gptr, o0, o1) do { \
        __builtin_amdgcn_global_load_lds((const unsigned*)((const char*)(gptr) + (o0)), (LAS unsigned*)(lds + (bufoff) + ldsw), 16, 0, 0); \
        __builtin_amdgcn_global_load_lds((const unsigned*)((const char*)(gptr) + (o1)), (LAS unsigned*)(lds + (bufoff) + ldsw + 8192), 16, 0, 0); } while (0)
#define PG8_STB(bufoff, gptr) PG8_GL(bufoff, gptr, voffB[0], voffB[1])
#define PG8_STA(bufoff, gptr, h, nx) do { if constexpr (GATHER) { const unsigned _o0 = (nx) ? gn[h][0] : gc[h][0], _o1 = (nx) ? gn[h][1] : gc[h][1]; PG8_GL(bufoff, gptr, _o0, _o1); } \
        else { PG8_GL(bufoff, (gptr) + (h) * hstepA, voffA[0], voffA[1]); } } while (0)
#define PG8_LDA(dst, b, h) do { _Pragma("unroll") for (int m = 0; m < 4; ++m) _Pragma("unroll") for (int k = 0; k < 2; ++k) dst[m][k] = *(const LAS bf16x8*)(lds + PG8_SA(b, h) + aoff + m * 2048 + k * 1024); } while (0)
#define PG8_LDB(dst, b, h) do { _Pragma("unroll") for (int n = 0; n < 2; ++n) _Pragma("unroll") for (int k = 0; k < 2; ++k) dst[n][k] = *(const LAS bf16x8*)(lds + PG8_SB(b, h) + boff + n * 2048 + k * 1024); } while (0)
#define PG8_MMA(ai, bj, At, Bt) do { __builtin_amdgcn_s_setprio(1); _Pragma("unroll") for (int m = 0; m < 4; ++m) _Pragma("unroll") for (int n = 0; n < 2; ++n) _Pragma("unroll") for (int k = 0; k < 2; ++k) \
        acc[ai][bj][m][n] = __builtin_amdgcn_mfma_f32_16x16x32_bf16(Bt[n][k], At[m][k], acc[ai][bj][m][n], 0, 0, 0); __builtin_amdgcn_s_setprio(0); } while (0)
#if DBG_SAFE
#define PG8_WAIT_V(n) asm volatile("s_waitcnt vmcnt(0)" ::: "memory")
#else
#define PG8_WAIT_V(n) asm volatile("s_waitcnt vmcnt(" #n ")" ::: "memory")
#endif
#define PG8_WAIT_L(n) asm volatile("s_waitcnt lgkmcnt(" #n ")" ::: "memory")
#define PG8_BAR __builtin_amdgcn_s_barrier()
#define PG8_SCHED __builtin_amdgcn_sched_barrier(0)
    Unit cur, nxt; int ui = 0;
    if (!S.next(0, cur)) return;
    unsigned gc[2][2], gn[2][2];
    if constexpr (GATHER) {
#pragma unroll
        for (int h = 0; h < 2; ++h)
#pragma unroll
            for (int i = 0; i < 2; ++i) { const int rr = h * HALF + RA[i]; const int idx = rr < cur.nvalid ? cur.rows[rr] : 0; gc[h][i] = (unsigned)idx * lda + (unsigned)CA2[i]; gn[h][i] = gc[h][i]; }
    }
    f32x4 acc[2][2][4][2];
#pragma unroll
    for (int a = 0; a < 2; ++a)
#pragma unroll
        for (int b = 0; b < 2; ++b)
#pragma unroll
            for (int m = 0; m < 4; ++m)
#pragma unroll
                for (int n = 0; n < 2; ++n) acc[a][b][m][n] = (f32x4){0.f, 0.f, 0.f, 0.f};
    bf16x8 At[4][2], B0[2][2], B1[2][2];
    const char* cA = cur.a; const char* cB = cur.b;
    PG8_STB(PG8_SB(0, 0), cB); PG8_STB(PG8_SB(0, 1), cB + hstepB); PG8_STA(PG8_SA(0, 0), cA, 0, false); PG8_STA(PG8_SA(0, 1), cA, 1, false);
    if (wr == 1) PG8_BAR;
    PG8_WAIT_V(2); PG8_BAR;
    PG8_STB(PG8_SB(1, 0), cB + kstep); PG8_STA(PG8_SA(1, 0), cA + kstep, 0, false); PG8_STB(PG8_SB(1, 1), cB + hstepB + kstep);
    PG8_WAIT_V(6); PG8_BAR;
    for (;;) {
        const bool has_next = S.next(ui + 1, nxt);
        const char* nA = has_next ? nxt.a : cA; const char* nB = has_next ? nxt.b : cB;
        if constexpr (GATHER) {
            if (has_next) {
#pragma unroll
                for (int h = 0; h < 2; ++h)
#pragma unroll
                    for (int i = 0; i < 2; ++i) { const int rr = h * HALF + RA[i]; const int idx = rr < nxt.nvalid ? nxt.rows[rr] : 0; gn[h][i] = (unsigned)idx * lda + (unsigned)CA2[i]; }
            } else {
#pragma unroll
                for (int h = 0; h < 2; ++h)
#pragma unroll
                    for (int i = 0; i < 2; ++i) gn[h][i] = gc[h][i];
            }
        }
        for (int t = 0; t < nt; t += 2) {
            const bool last = (t == nt - 2);
            const char* a1 = cA + (size_t)(t + 1) * kstep;
            const char* a2 = last ? nA : cA + (size_t)(t + 2) * kstep; const char* b2 = last ? nB : cB + (size_t)(t + 2) * kstep;
            const char* a3 = a2 + kstep; const char* b3 = b2 + kstep;
            PG8_LDB(B0, 0, 0); PG8_LDB(B1, 0, 1); PG8_SCHED; PG8_LDA(At, 0, 0); PG8_STA(PG8_SA(1, 1), a1, 1, false);
            PG8_WAIT_V(8); PG8_WAIT_L(0); PG8_BAR; PG8_MMA(0, 0, At, B0); PG8_MMA(0, 1, At, B1); PG8_BAR; PG8_SCHED;
            PG8_LDA(At, 0, 1); PG8_STB(PG8_SB(0, 0), b2); PG8_STB(PG8_SB(0, 1), b2 + hstepB); PG8_STA(PG8_SA(0, 0), a2, 0, last);
            PG8_WAIT_V(8); PG8_WAIT_L(0); PG8_BAR; PG8_MMA(1, 0, At, B0); PG8_MMA(1, 1, At, B1); PG8_BAR; PG8_SCHED;
            PG8_LDB(B0, 1, 0); PG8_LDB(B1, 1, 1); PG8_SCHED; PG8_LDA(At, 1, 0); PG8_STA(PG8_SA(0, 1), a2, 1, last);
            PG8_WAIT_V(8); PG8_WAIT_L(0); PG8_BAR; PG8_MMA(0, 0, At, B0); PG8_MMA(0, 1, At, B1); PG8_BAR; PG8_SCHED;
            PG8_LDA(At, 1, 1); PG8_STB(PG8_SB(1, 0), b3); PG8_STB(PG8_SB(1, 1), b3 + hstepB); PG8_STA(PG8_SA(1, 0), a3, 0, last);
            PG8_WAIT_V(8); PG8_WAIT_L(0); PG8_BAR; PG8_MMA(1, 0, At, B0); PG8_MMA(1, 1, At, B1); PG8_BAR; PG8_SCHED;
        }
        if (wr == 0) PG8_BAR;
        asm volatile("s_nop 15\n\ts_nop 15" ::: "memory");
        const bool keep = E(acc, cur, wr, wc, fr, fq);
        if (!has_next) break;
        if (!keep) {
#pragma unroll
            for (int a = 0; a < 2; ++a)
#pragma unroll
                for (int b = 0; b < 2; ++b)
#pragma unroll
                    for (int m = 0; m < 4; ++m)
#pragma unroll
                        for (int n = 0; n < 2; ++n) acc[a][b][m][n] = (f32x4){0.f, 0.f, 0.f, 0.f};
        }
        cur = nxt; cA = nA; cB = nB; ++ui;
        if constexpr (GATHER) {
#pragma unroll
            for (int h = 0; h < 2; ++h)
#pragma unroll
                for (int i = 0; i < 2; ++i) gc[h][i] = gn[h][i];
        }
        if (wr == 1) PG8_BAR;
    }
    PG8_WAIT_V(0);
    PG8_BAR;
#undef PG8_SA
#undef PG8_SB
#undef PG8_GL
#undef PG8_STB
#undef PG8_STA
#undef PG8_LDA
#undef PG8_LDB
#undef PG8_MMA
#undef PG8_WAIT_V
#undef PG8_WAIT_L
#undef PG8_BAR
#undef PG8_SCHED
}

template <class Epi, class Sched, bool GATHER>
DI void gemm_phase_simple(LAS unsigned char* lds, const int wid, const int K, const unsigned lda, const unsigned ldb, const Sched& S, const Epi& E) {
    const int lane = lane_id_asm(), tid = wid * 64 + lane; const int wr = wid >> 2, wc = wid & 3, fr = lane & 15, fq = lane >> 4;
    const int nt = K / BK;
    unsigned voffA[2], voffB[2]; int RA[2], CA2[2];
#pragma unroll
    for (int i = 0; i < 2; ++i) { int R, C; stage_rc(tid * 16 + i * 8192, R, C); const int Rb = Epi::PERM ? ((R & ~31) + perm32(R & 31)) : R;
        RA[i] = R; CA2[i] = C * 2; voffA[i] = (unsigned)R * lda + (unsigned)C * 2u; voffB[i] = (unsigned)Rb * ldb + (unsigned)C * 2u; }
    const size_t hstepA = (size_t)HALF * lda, hstepB = (size_t)HALF * ldb;
    const int aoff = lds_byte(wr * 64 + fr, fq * 8), boff = lds_byte(wc * 32 + fr, fq * 8);
    Unit cur;
    f32x4 acc[2][2][4][2];
#pragma unroll
        for (int a = 0; a < 2; ++a)
#pragma unroll
            for (int b = 0; b < 2; ++b)
#pragma unroll
                for (int m = 0; m < 4; ++m)
#pragma unroll
                    for (int n = 0; n < 2; ++n) acc[a][b][m][n] = (f32x4){0.f, 0.f, 0.f, 0.f};
    for (int ui = 0; S.next(ui, cur); ++ui) {
        unsigned ga[2][2];
#pragma unroll
        for (int h = 0; h < 2; ++h)
#pragma unroll
            for (int i = 0; i < 2; ++i) {
                if constexpr (GATHER) { const int rr = h * HALF + RA[i]; const int idx = rr < cur.nvalid ? cur.rows[rr] : 0; ga[h][i] = (unsigned)idx * lda + (unsigned)CA2[i]; }
                else ga[h][i] = (unsigned)(h * hstepA) + voffA[i];
            }
        for (int t = 0; t < nt; ++t) {
            v4u ra[2][2], rb[2][2];
#pragma unroll
            for (int h = 0; h < 2; ++h)
#pragma unroll
                for (int i = 0; i < 2; ++i) { ra[h][i] = *(const v4u*)(cur.a + (size_t)t * 128 + ga[h][i]); rb[h][i] = *(const v4u*)(cur.b + (size_t)t * 128 + h * hstepB + voffB[i]); }
            __syncthreads();
#pragma unroll
            for (int h = 0; h < 2; ++h)
#pragma unroll
                for (int i = 0; i < 2; ++i) { *(LAS v4u*)(lds + h * HTB + tid * 16 + i * 8192) = ra[h][i]; *(LAS v4u*)(lds + (4 + h) * HTB + tid * 16 + i * 8192) = rb[h][i]; }
            __syncthreads();
#pragma unroll
            for (int ai = 0; ai < 2; ++ai) {
                bf16x8 At[4][2];
#pragma unroll
                for (int m = 0; m < 4; ++m)
#pragma unroll
                    for (int k = 0; k < 2; ++k) At[m][k] = *(const LAS bf16x8*)(lds + ai * HTB + aoff + m * 2048 + k * 1024);
#pragma unroll
                for (int bj = 0; bj < 2; ++bj) {
                    bf16x8 Bt[2][2];
#pragma unroll
                    for (int n = 0; n < 2; ++n)
#pragma unroll
                        for (int k = 0; k < 2; ++k) Bt[n][k] = *(const LAS bf16x8*)(lds + (4 + bj) * HTB + boff + n * 2048 + k * 1024);
#pragma unroll
                    for (int m = 0; m < 4; ++m)
#pragma unroll
                        for (int n = 0; n < 2; ++n)
#pragma unroll
                            for (int k = 0; k < 2; ++k) acc[ai][bj][m][n] = __builtin_amdgcn_mfma_f32_16x16x32_bf16(Bt[n][k], At[m][k], acc[ai][bj][m][n], 0, 0, 0);
                }
            }
        }
        asm volatile("s_nop 15\n\ts_nop 15" ::: "memory");
        const bool keep = E(acc, cur, wr, wc, fr, fq);
        if (!keep) {
#pragma unroll
            for (int a = 0; a < 2; ++a)
#pragma unroll
                for (int b = 0; b < 2; ++b)
#pragma unroll
                    for (int m = 0; m < 4; ++m)
#pragma unroll
                        for (int n = 0; n < 2; ++n) acc[a][b][m][n] = (f32x4){0.f, 0.f, 0.f, 0.f};
        }
    }
    __syncthreads();
}
}
using pg8::Unit;
#if GEMM_SIMPLE
#define GEMM_PHASE gemm_phase_simple
#else
#define GEMM_PHASE gemm_phase
#endif

struct Params {
    const float* in[34];
    float* out; unsigned char* ws;
    int ph_lo, ph_hi;
};
enum { I_X = 0, I_C, I_CTX, I_CCTX, I_WADA, I_BADA, I_NMG, I_NFG, I_WIN, I_CONVW, I_CONVB, I_CLNG, I_CLNB, I_LCW, I_LCB, I_LWA, I_LBA, I_LWX, I_LBX, I_LLAM,
       I_QNG, I_KNG, I_SINK, I_POOLW, I_POOLS, I_WBR, I_WGATE, I_BGATE, I_WOUT, I_WROUTER, I_RBIAS, I_EWG, I_EWU, I_EWD };
struct Frame {
    LAS unsigned char* lds;
    unsigned* ctl;
    int tid, lane, wave, G, bid;
    const Params* p;
    unsigned char* ws;
};
#define WSP(T, off) ((T*)(F.ws + (off)))

DI void mod_gemv(Frame& F) {
    if (F.bid >= 192) return;
    const int l = F.bid / 96, col0 = (F.bid % 96) * 128;
    LAS float* sc9 = (LAS float*)F.lds;
    LAS float* red = (LAS float*)(F.lds + 73728);
    const float* c = F.p->in[I_C]; const float* cc = F.p->in[I_CCTX];
    for (int i = F.tid; i < 9 * D; i += 512) { const int r = i / D, k = i % D; const float v = (r < 8) ? c[r * D + k] : cc[k]; sc9[i] = siluf_(v); }
    __syncthreads();
    float acc[9][2];
#pragma unroll
    for (int r = 0; r < 9; ++r) { acc[r][0] = 0.f; acc[r][1] = 0.f; }
    const int k0 = F.wave * 256;
    const float2* wp = (const float2*)(F.p->in[I_WADA] + (size_t)l * D * MODW + (size_t)k0 * MODW + col0 + 2 * F.lane);
#pragma unroll 8
    for (int kk = 0; kk < 256; ++kk) {
        const float2 wv = wp[(size_t)kk * (MODW / 2)];
#pragma unroll
        for (int r = 0; r < 9; ++r) { const float s = sc9[r * D + k0 + kk]; acc[r][0] += s * wv.x; acc[r][1] += s * wv.y; }
    }
#pragma unroll
    for (int r = 0; r < 9; ++r) { red[(F.wave * 9 + r) * 128 + 2 * F.lane] = acc[r][0]; red[(F.wave * 9 + r) * 128 + 2 * F.lane + 1] = acc[r][1]; }
    __syncthreads();
    float* mod = WSP(float, WS_MOD);
    const float* bada = F.p->in[I_BADA];
    for (int i = F.tid; i < 9 * 128; i += 512) { const int r = i / 128, n = i % 128; float s = 0.f;
#pragma unroll
        for (int w = 0; w < 8; ++w) s += red[(w * 9 + r) * 128 + n];
        mod[(size_t)(l * 9 + r) * MODW + col0 + n] = s + bada[l * MODW + col0 + n]; }
    __syncthreads();
}

DI void cvt_item(const float* W, int Nsrc, int k0, int n0, bf16* WT, size_t drow0, int Kd, LAS float* scr, int lane) {
#pragma unroll 8
    for (int i = 0; i < 32; ++i) { const int kk = 2 * i + (lane >> 5); scr[kk * 33 + (lane & 31)] = W[(size_t)(k0 + kk) * Nsrc + n0 + (lane & 31)]; }
    LDS_WAIT(); asm volatile("" ::: "memory");
    const int c = lane & 7;
#pragma unroll
    for (int j = 0; j < 4; ++j) { const int n = (lane >> 3) + 8 * j; const LAS float* s = scr + (8 * c) * 33 + n;
        v4u o; o.x = pk2(s[0 * 33], s[1 * 33]); o.y = pk2(s[2 * 33], s[3 * 33]); o.z = pk2(s[4 * 33], s[5 * 33]); o.w = pk2(s[6 * 33], s[7 * 33]);
        *(v4u*)(WT + (drow0 + n) * (size_t)Kd + k0 + 8 * c) = o; }
    LDS_WAIT(); asm volatile("" ::: "memory");
}
DI int win_dst(int n) {
    if (n < 512) return U_AU + n; if (n < 1024) return U_AG + (n - 512); if (n < 1536) return U_RX + (n - 1024); if (n < 2048) return U_RG + (n - 1536);
    if (n < 2560) return U_Q + (n - 2048); if (n < 2688) return U_K + (n - 2560); if (n < 2816) return U_V + (n - 2688); return U_P + (n - 2816);
}
DI void convert_weights(Frame& F, int l) {
    LAS float* scr = (LAS float*)(F.lds + F.wave * 16384);
    const int gw = F.bid * 8 + F.wave, NGW = F.G * 8;
    constexpr int I1 = 32 * 104, I2 = 4 * 32 * 64, I3 = 4 * 8 * 64, I4 = 32 * 64, I5 = 16 * 32 * 32, I6 = I5, I7 = 16 * 16 * 64, I8 = 16 * 2, I9 = 16 * 2, I10 = 4 * 2 * 4;
    constexpr int NIT = I1 + I2 + I3 + I4 + I5 + I6 + I7 + I8 + I9 + I10;
    bf16* W2 = WSP(bf16, WS_W2); bf16* WB = WSP(bf16, WS_WB); bf16* WO = WSP(bf16, WS_WO); bf16* WGU = WSP(bf16, WS_WGU); bf16* WD = WSP(bf16, WS_WD);
    bf16* WL = WSP(bf16, WS_SMALLW + SW_LRU); bf16* WP = WSP(bf16, WS_SMALLW + SW_POOL);
    for (int it = gw; it < NIT; it += NGW) {
        int r = it;
        if (r < I1) { const int kb = r / 104, nb = r % 104; cvt_item(F.p->in[I_WIN] + (size_t)l * D * INC, INC, kb * 64, nb * 32, W2, (size_t)win_dst(nb * 32), D, scr, F.lane); continue; } r -= I1;
        if (r < I2) { const int g = r / 2048, q = r % 2048, kb = q / 64, nb = q % 64; cvt_item(F.p->in[I_WGATE] + ((size_t)l * 4 + g) * D * D, D, kb * 64, nb * 32, W2, (size_t)INC + g * D + nb * 32, D, scr, F.lane); continue; } r -= I2;
        if (r < I3) { const int g = r / 512, q = r % 512, kb = q / 64, nb = q % 64; cvt_item(F.p->in[I_WBR] + ((size_t)l * 4 + g) * BRW * D, D, kb * 64, nb * 32, WB, (size_t)g * D + nb * 32, BRW, scr, F.lane); continue; } r -= I3;
        if (r < I4) { const int kb = r / 64, nb = r % 64; cvt_item(F.p->in[I_WOUT] + (size_t)l * D * D, D, kb * 64, nb * 32, WO, (size_t)nb * 32, D, scr, F.lane); continue; } r -= I4;
        if (r < I5) { const int e = r / 1024, q = r % 1024, kb = q / 32, nb = q % 32, n = nb * 32; cvt_item(F.p->in[I_EWG] + ((size_t)l * NE + e) * D * DE, DE, kb * 64, n, WGU, (size_t)e * 2048 + (n / 128) * 256 + (n % 128), D, scr, F.lane); continue; } r -= I5;
        if (r < I6) { const int e = r / 1024, q = r % 1024, kb = q / 32, nb = q % 32, n = nb * 32; cvt_item(F.p->in[I_EWU] + ((size_t)l * NE + e) * D * DE, DE, kb * 64, n, WGU, (size_t)e * 2048 + (n / 128) * 256 + 128 + (n % 128), D, scr, F.lane); continue; } r -= I6;
        if (r < I7) { const int e = r / 1024, q = r % 1024, kb = q / 64, nb = q % 64; cvt_item(F.p->in[I_EWD] + ((size_t)l * NE + e) * DE * D, D, kb * 64, nb * 32, WD, (size_t)e * 2048 + nb * 32, DE, scr, F.lane); continue; } r -= I7;
        if (r < I8) { const int mat = r / 2, nb = r % 2;
            const int d = mat / 8, h = mat % 8; cvt_item(F.p->in[I_LWA] + (((size_t)l * 2 + d) * 8 + h) * 4096, 64, 0, nb * 32, WL, (size_t)((d * 2 + 0) * 8 + h) * 64 + nb * 32, 64, scr, F.lane); continue; } r -= I8;
        if (r < I9) { const int mat = r / 2, nb = r % 2;
            const int d = mat / 8, h = mat % 8; cvt_item(F.p->in[I_LWX] + (((size_t)l * 2 + d) * 8 + h) * 4096, 64, 0, nb * 32, WL, (size_t)((d * 2 + 1) * 8 + h) * 64 + nb * 32, 64, scr, F.lane); continue; } r -= I9;
        { const int g = r / 8, q = r % 8, kb = q / 4, nb = q % 4; cvt_item(F.p->in[I_POOLW] + ((size_t)l * 4 + g) * 16384, 128, kb * 64, nb * 32, WP, (size_t)g * 128 + nb * 32, 128, scr, F.lane); }
    }
}

constexpr int LC_SCR = LDSCTL_OFF + 256;

DI void norm_phase(Frame& F, int l, int mode) {
    const int gw = F.bid * 8 + F.wave, NGW = F.G * 8;
    LAS int* offs = (LAS int*)(F.lds + LC_SCR);
    const int lp = (mode == 1) ? l - 1 : DEPTH - 1;
    if (mode != 0) {
        if (F.tid == 0) { int acc = 0; for (int e = 0; e < NE; ++e) { const int c = (int)__hip_atomic_load(F.ctl + CW_CNT + (lp * 16 + e) * 64, __ATOMIC_RELAXED, __HIP_MEMORY_SCOPE_AGENT); offs[e] = acc * 256; acc += (c + 255) >> 8; } }
        __syncthreads();
    }
    const int nrows = (mode == 2) ? TL : MT;
    const float* mod = WSP(float, WS_MOD);
    const int* tokslot = (const int*)(F.ws + WS_LIST + LIST_TS);
    const bf16* O = WSP(bf16, WS_O);
    bf16* H = WSP(bf16, WS_H);
    for (int row = gw; row < nrows; row += NGW) {
        const bool lat = row < TL; const int bidx = lat ? row / SEQ : 8;
        const float* xs; float* xd = nullptr;
        if (mode == 0) xs = lat ? F.p->in[I_X] + (size_t)row * D : F.p->in[I_CTX] + (size_t)(row - TL) * D;
        else { xd = lat ? F.p->out + (size_t)row * D : WSP(float, WS_XC) + (size_t)(row - TL) * D; xs = xd; }
        f32x4 v[8];
#pragma unroll
        for (int j = 0; j < 8; ++j) v[j] = ((const f32x4*)xs)[F.lane + 64 * j];
        if (mode != 0) {
            const int s0 = tokslot[row * 2], s1 = tokslot[row * 2 + 1];
            const size_t sl0 = (size_t)(offs[s0 >> 20] + (s0 & 0xfffff)), sl1 = (size_t)(offs[s1 >> 20] + (s1 & 0xfffff));
            const float* g2 = mod + (size_t)(lp * 9 + bidx) * MODW + MO_G2;
#pragma unroll
            for (int j = 0; j < 8; ++j) {
                const v2u o0 = *(const v2u*)(O + sl0 * D + 4 * F.lane + 256 * j), o1 = *(const v2u*)(O + sl1 * D + 4 * F.lane + 256 * j);
                const f32x4 gv = ((const f32x4*)g2)[F.lane + 64 * j];
                v[j].x += gv.x * (bflo(o0.x) + bflo(o1.x)); v[j].y += gv.y * (bfhi(o0.x) + bfhi(o1.x));
                v[j].z += gv.z * (bflo(o0.y) + bflo(o1.y)); v[j].w += gv.w * (bfhi(o0.y) + bfhi(o1.y));
                ((f32x4*)xd)[F.lane + 64 * j] = v[j];
            }
        }
        if (mode != 2) {
            float ss = 0.f;
#pragma unroll
            for (int j = 0; j < 8; ++j) ss += (v[j].x * v[j].x + v[j].y * v[j].y) + (v[j].z * v[j].z + v[j].w * v[j].w);
            ss = wave_sum(ss);
            const float r = 1.0f / sqrtf(ss * (1.0f / D) + EPS);
            const float* gain = F.p->in[I_NMG] + l * D; const float* sh = mod + (size_t)(l * 9 + bidx) * MODW + MO_SH1; const float* sc = mod + (size_t)(l * 9 + bidx) * MODW + MO_SC1;
#pragma unroll
            for (int j = 0; j < 8; ++j) {
                const f32x4 gn = ((const f32x4*)gain)[F.lane + 64 * j], s_ = ((const f32x4*)sc)[F.lane + 64 * j], b_ = ((const f32x4*)sh)[F.lane + 64 * j];
                const float h0 = (v[j].x * r) * gn.x * (1.0f + s_.x) + b_.x, h1 = (v[j].y * r) * gn.y * (1.0f + s_.y) + b_.y;
                const float h2 = (v[j].z * r) * gn.z * (1.0f + s_.z) + b_.z, h3 = (v[j].w * r) * gn.w * (1.0f + s_.w) + b_.w;
                v2u o; o.x = pk2(h0, h1); o.y = pk2(h2, h3);
                *(v2u*)(H + (size_t)row * D + 4 * F.lane + 256 * j) = o;
            }
        }
    }
}

DI void router_phase(Frame& F, int l) {
    const int gw = F.bid * 8 + F.wave, NGW = F.G * 8;
    const int nrows = (l == 0) ? MT : TL;
    LAS float* wr = (LAS float*)F.lds;
    LAS int* asg_e = (LAS int*)(F.lds + LC_SCR);
    LAS float* asg_w = (LAS float*)(F.lds + LC_SCR + 1088);
    LAS int* asg_r = (LAS int*)(F.lds + LC_SCR + 2176);
    const float* wrt = F.p->in[I_WROUTER];
    for (int s = F.tid; s < D * NE; s += 512) { const int c = s >> 4, e = s & 15, j = c >> 8, ln = (c & 255) >> 2, i = c & 3; wr[((((j * 4 + i) * 4 + (e >> 2)) * 64 + ln) << 2) + (e & 3)] = wrt[s]; }
    for (int s = F.tid; s < 272; s += 512) asg_e[s] = -1;
    __syncthreads();
    const float* mod = WSP(float, WS_MOD);
    bf16* H2 = WSP(bf16, WS_H);
    float rb[16];
#pragma unroll
    for (int e = 0; e < 16; ++e) rb[e] = F.p->in[I_RBIAS][e];
    int it = 0;
    for (int row = gw; row < nrows; row += NGW, ++it) {
        const bool lat = row < TL; const int bidx = lat ? row / SEQ : 8;
        const float* xs = lat ? F.p->out + (size_t)row * D : WSP(float, WS_XC) + (size_t)(row - TL) * D;
        f32x4 v[8];
#pragma unroll
        for (int j = 0; j < 8; ++j) v[j] = ((const f32x4*)xs)[F.lane + 64 * j];
        float ss = 0.f;
#pragma unroll
        for (int j = 0; j < 8; ++j) ss += (v[j].x * v[j].x + v[j].y * v[j].y) + (v[j].z * v[j].z + v[j].w * v[j].w);
        ss = wave_sum(ss);
        const float r = 1.0f / sqrtf(ss * (1.0f / D) + EPS);
        const float* gain = F.p->in[I_NFG] + l * D; const float* sh = mod + (size_t)(l * 9 + bidx) * MODW + MO_SH2; const float* sc = mod + (size_t)(l * 9 + bidx) * MODW + MO_SC2;
        f32x4 pl[4];
#pragma unroll
        for (int q = 0; q < 4; ++q) pl[q] = (f32x4){0.f, 0.f, 0.f, 0.f};
#pragma unroll
        for (int j = 0; j < 8; ++j) {
            const f32x4 gn = ((const f32x4*)gain)[F.lane + 64 * j], s_ = ((const f32x4*)sc)[F.lane + 64 * j], b_ = ((const f32x4*)sh)[F.lane + 64 * j];
            float hv[4];
            hv[0] = (v[j].x * r) * gn.x * (1.0f + s_.x) + b_.x; hv[1] = (v[j].y * r) * gn.y * (1.0f + s_.y) + b_.y;
            hv[2] = (v[j].z * r) * gn.z * (1.0f + s_.z) + b_.z; hv[3] = (v[j].w * r) * gn.w * (1.0f + s_.w) + b_.w;
            v2u o; o.x = pk2(hv[0], hv[1]); o.y = pk2(hv[2], hv[3]);
            *(v2u*)(H2 + (size_t)row * D + 4 * F.lane + 256 * j) = o;
#pragma unroll
            for (int i = 0; i < 4; ++i)
#pragma unroll
                for (int q = 0; q < 4; ++q) { const f32x4 w4 = *(const LAS f32x4*)(wr + ((((j * 4 + i) * 4 + q) * 64 + F.lane) << 2)); pl[q] += hv[i] * w4; }
        }
        float sel[16], sco[16];
#pragma unroll
        for (int q = 0; q < 4; ++q) {
            const float l0 = wave_sum(pl[q].x), l1 = wave_sum(pl[q].y), l2 = wave_sum(pl[q].z), l3 = wave_sum(pl[q].w);
            sco[4 * q + 0] = 1.0f / (1.0f + expf(-l0)); sco[4 * q + 1] = 1.0f / (1.0f + expf(-l1)); sco[4 * q + 2] = 1.0f / (1.0f + expf(-l2)); sco[4 * q + 3] = 1.0f / (1.0f + expf(-l3));
        }
#pragma unroll
        for (int e = 0; e < 16; ++e) sel[e] = sco[e] + rb[e];
        float bestv = 0.f; int best = 0;
#pragma unroll
        for (int g = 0; g < 4; ++g) {
            const float a = sel[4 * g], b = sel[4 * g + 1], c = sel[4 * g + 2], d = sel[4 * g + 3];
            const float hi1 = fmaxf(a, b), lo1 = fminf(a, b), hi2 = fmaxf(c, d), lo2 = fminf(c, d);
            const float gs = fmaxf(hi1, hi2) + fmaxf(fminf(hi1, hi2), fmaxf(lo1, lo2));
            if (g == 0 || gs > bestv) { bestv = gs; best = g; }
        }
        float cs[4], ss4[4];
#pragma unroll
        for (int k = 0; k < 4; ++k) { cs[k] = best == 0 ? sel[k] : best == 1 ? sel[4 + k] : best == 2 ? sel[8 + k] : sel[12 + k]; ss4[k] = best == 0 ? sco[k] : best == 1 ? sco[4 + k] : best == 2 ? sco[8 + k] : sco[12 + k]; }
        int k1 = 0; float v1 = cs[0], s1 = ss4[0];
#pragma unroll
        for (int k = 1; k < 4; ++k) if (cs[k] > v1) { v1 = cs[k]; k1 = k; s1 = ss4[k]; }
        int k2 = -1; float v2 = 0.f, s2 = 0.f;
#pragma unroll
        for (int k = 0; k < 4; ++k) if (k != k1 && (k2 < 0 || cs[k] > v2)) { v2 = cs[k]; k2 = k; s2 = ss4[k]; }
        if (F.lane == 0) {
            const int a = (F.wave * 17 + it) * 2; const float inv = 1.0f / (s1 + s2);
            asg_e[a] = best * 4 + k1; asg_w[a] = s1 * inv; asg_r[a] = row;
            asg_e[a + 1] = best * 4 + k2; asg_w[a + 1] = s2 * inv; asg_r[a + 1] = row;
        }
    }
    __syncthreads();
    if (F.tid < NE) {
        const int e = F.tid; int cn = 0;
        for (int a = 0; a < 272; ++a) cn += (asg_e[a] == e) ? 1 : 0;
        int run = cn ? (int)__hip_atomic_fetch_add(F.ctl + CW_CNT + (l * 16 + e) * 64, (unsigned)cn, __ATOMIC_RELAXED, __HIP_MEMORY_SCOPE_AGENT) : 0;
        int* rowlist = (int*)(F.ws + WS_LIST + LIST_ROW); float* wlist = (float*)(F.ws + WS_LIST + LIST_W); int* tokslot = (int*)(F.ws + WS_LIST + LIST_TS);
        for (int a = 0; a < 272; ++a) if (asg_e[a] == e) { const int row = asg_r[a]; rowlist[(size_t)e * ECAP + run] = row; wlist[(size_t)e * ECAP + run] = asg_w[a]; tokslot[row * 2 + (a & 1)] = (e << 20) | run; ++run; }
    }
    __syncthreads();
}

DI void qk_prep(Frame& F, int l) {
    const int gw = F.bid * 8 + F.wave, NGW = F.G * 8;
    bf16* U = WSP(bf16, WS_U);
    const float qg = F.p->in[I_QNG][l * 64 + F.lane], kg = F.p->in[I_KNG][l * 64 + F.lane];
    const int fi = F.lane & 15; const float inv = powf(10000.0f, -(float)fi * (1.0f / 16.0f));
    for (int row = gw; row < MT; row += NGW) {
        const bool lat = row < TL;
        float cs = 1.f, sn = 0.f;
        if (lat) { const int t = row % SEQ; const float pos = ((F.lane & 31) < 16) ? (float)(t / 64) : (float)(t % 64); const float ang = pos * inv; cs = __cosf(ang); sn = __sinf(ang); }
        const int h0 = (lat || l == 0) ? 0 : 8;
        for (int hd = h0; hd < 10; ++hd) {
            bf16* p = U + (size_t)row * INC + (hd < 8 ? U_Q + hd * 64 : U_K + (hd - 8) * 64) + F.lane;
            const float x = bf2f(*p);
            const float ss = wave_sum(x * x);
            const float r = 1.0f / sqrtf(ss * (1.0f / 64.0f) + EPS);
            const float xn = (x * r) * (hd < 8 ? qg : kg);
            float o = xn;
            if (lat) { const float pr = __shfl_xor(xn, 32); o = (F.lane < 32) ? (xn * cs - pr * sn) : (pr * sn + xn * cs); }
            *p = (bf16)f2bf(o);
        }
    }
}

DI void conv_unit(Frame& F, int l, int cu) {
    const bf16* U = WSP(bf16, WS_U); bf16* BR = WSP(bf16, WS_BR);
    LAS float* Y = (LAS float*)F.lds;
    const int r0 = cu * 32;
    const int seq_lo = (r0 < TL) ? (r0 / SEQ) * SEQ : TL + ((r0 - TL) / CTX) * CTX, seq_hi = seq_lo + ((r0 < TL) ? SEQ : CTX);
    { const int cv = F.tid & 63, rg = F.tid >> 6;
      for (int i = rg; i < 62; i += 8) {
          const int row = r0 - 15 + i; f32x4 y0 = (f32x4){0.f, 0.f, 0.f, 0.f}, y1 = y0;
          if (row >= seq_lo && row < seq_hi) {
              const v4u u = *(const v4u*)(U + (size_t)row * INC + U_AU + 8 * cv), g = *(const v4u*)(U + (size_t)row * INC + U_AG + 8 * cv);
              y0.x = bflo(u.x) * sigmoidf_(bflo(g.x)); y0.y = bfhi(u.x) * sigmoidf_(bfhi(g.x)); y0.z = bflo(u.y) * sigmoidf_(bflo(g.y)); y0.w = bfhi(u.y) * sigmoidf_(bfhi(g.y));
              y1.x = bflo(u.z) * sigmoidf_(bflo(g.z)); y1.y = bfhi(u.z) * sigmoidf_(bfhi(g.z)); y1.z = bflo(u.w) * sigmoidf_(bflo(g.w)); y1.w = bfhi(u.w) * sigmoidf_(bfhi(g.w));
          }
          *(LAS f32x4*)(Y + i * 512 + 8 * cv) = y0; *(LAS f32x4*)(Y + i * 512 + 8 * cv + 4) = y1;
      } }
    __syncthreads();
    { const int c = F.tid; float w[31];
      const float* cw = F.p->in[I_CONVW] + (size_t)l * 31 * BRW;
#pragma unroll
      for (int j = 0; j < 31; ++j) w[j] = cw[j * BRW + c];
      const float bias = F.p->in[I_CONVB][l * BRW + c];
      for (int tb = 0; tb < 4; ++tb) {
          float z[8];
#pragma unroll
          for (int k = 0; k < 8; ++k) z[k] = bias;
#pragma unroll
          for (int j = 0; j < 38; ++j) { const float yv = Y[(8 * tb + j) * 512 + c];
#pragma unroll
              for (int k = 0; k < 8; ++k) { const int tap = j - k; if (tap >= 0 && tap < 31) z[k] += w[tap] * yv; } }
#pragma unroll
          for (int k = 0; k < 8; ++k) Y[(8 * tb + k) * 512 + c] = z[k];
      } }
    __syncthreads();
    { const float* lg = F.p->in[I_CLNG] + l * BRW + 8 * F.lane; const float* lb = F.p->in[I_CLNB] + l * BRW + 8 * F.lane;
      const f32x4 g0 = *(const f32x4*)lg, g1 = *(const f32x4*)(lg + 4), b0 = *(const f32x4*)lb, b1 = *(const f32x4*)(lb + 4);
      for (int tk = F.wave; tk < 32; tk += 8) {
          f32x4 a = *(const LAS f32x4*)(Y + tk * 512 + 8 * F.lane), b = *(const LAS f32x4*)(Y + tk * 512 + 8 * F.lane + 4);
          const float mu = wave_sum((a.x + a.y) + (a.z + a.w) + (b.x + b.y) + (b.z + b.w)) * (1.0f / 512.0f);
          a = a - mu; b = b - mu;
          const float var = wave_sum((a.x * a.x + a.y * a.y) + (a.z * a.z + a.w * a.w) + (b.x * b.x + b.y * b.y) + (b.z * b.z + b.w * b.w)) * (1.0f / 512.0f);
          const float rs = 1.0f / sqrtf(var + EPS);
          a = a * rs * g0 + b0; b = b * rs * g1 + b1;
          v4u o; o.x = pk2(siluf_(a.x), siluf_(a.y)); o.y = pk2(siluf_(a.z), siluf_(a.w)); o.z = pk2(siluf_(b.x), siluf_(b.y)); o.w = pk2(siluf_(b.z), siluf_(b.w));
          *(v4u*)(BR + (size_t)(r0 + tk) * D + B_A + 8 * F.lane) = o;
      } }
    __syncthreads();
}

DI void pool_unit(Frame& F, int l, int pu) {
    const bf16* U = WSP(bf16, WS_U); bf16* BR = WSP(bf16, WS_BR);
    LAS unsigned char* Pin = F.lds;
    LAS unsigned char* Yl = F.lds + 49152;
    const int r0 = pu * 32;
    const int seq_lo = (r0 < TL) ? (r0 / SEQ) * SEQ : TL + ((r0 - TL) / CTX) * CTX, seq_hi = seq_lo + ((r0 < TL) ? SEQ : CTX);
    for (int q = F.tid; q < 47 * 64; q += 512) { const int i = q >> 6, cv = q & 63, row = r0 - 8 + i; v4u v = (v4u){0u, 0u, 0u, 0u};
        if (row >= seq_lo && row < seq_hi) v = *(const v4u*)(U + (size_t)row * INC + U_P + 8 * cv);
        *(LAS v4u*)(Pin + i * 1024 + cv * 16) = v; }
    __syncthreads();
    { const int tk = F.tid >> 4, row = r0 + tk;
#pragma unroll
      for (int g = 0; g < 4; ++g) { const int cv = (F.tid & 15) + 16 * g, hw = 1 << g;
          const int lo = max(row - hw, seq_lo), hi = min(row + hw, seq_hi);
          float s[8];
#pragma unroll
          for (int k = 0; k < 8; ++k) s[k] = 0.f;
          for (int rr = lo; rr < hi; ++rr) { const v4u v = *(const LAS v4u*)(Pin + (rr - r0 + 8) * 1024 + cv * 16);
              s[0] += bflo(v.x); s[1] += bfhi(v.x); s[2] += bflo(v.y); s[3] += bfhi(v.y); s[4] += bflo(v.z); s[5] += bfhi(v.z); s[6] += bflo(v.w); s[7] += bfhi(v.w); }
          const float ic = 1.0f / (float)(hi - lo);
          const v4u c = *(const LAS v4u*)(Pin + (tk + 8) * 1024 + cv * 16);
          v4u o; o.x = pk2(s[0] * ic - bflo(c.x), s[1] * ic - bfhi(c.x)); o.y = pk2(s[2] * ic - bflo(c.y), s[3] * ic - bfhi(c.y));
          o.z = pk2(s[4] * ic - bflo(c.z), s[5] * ic - bfhi(c.z)); o.w = pk2(s[6] * ic - bflo(c.w), s[7] * ic - bfhi(c.w));
          *(LAS v4u*)(Yl + tk * 1040 + cv * 16) = o; } }
    __syncthreads();
    { const int g = F.wave >> 1, hf = F.wave & 1, fr = F.lane & 15, fq = F.lane >> 4;
      const bf16* WP = WSP(bf16, WS_SMALLW + SW_POOL);
      f32x4 acc[2][4];
#pragma unroll
      for (int m = 0; m < 2; ++m)
#pragma unroll
          for (int n = 0; n < 4; ++n) acc[m][n] = (f32x4){0.f, 0.f, 0.f, 0.f};
#pragma unroll
      for (int s = 0; s < 4; ++s) {
          bf16x8 ya[2], wb[4];
#pragma unroll
          for (int m = 0; m < 2; ++m) ya[m] = *(const LAS bf16x8*)(Yl + (m * 16 + fr) * 1040 + (g * 128 + s * 32 + 8 * fq) * 2);
#pragma unroll
          for (int n = 0; n < 4; ++n) wb[n] = *(const bf16x8*)(WP + (size_t)(g * 128 + hf * 64 + n * 16 + fr) * 128 + s * 32 + 8 * fq);
#pragma unroll
          for (int m = 0; m < 2; ++m)
#pragma unroll
              for (int n = 0; n < 4; ++n) acc[m][n] = __builtin_amdgcn_mfma_f32_16x16x32_bf16(wb[n], ya[m], acc[m][n], 0, 0, 0);
      }
      const float* ps = F.p->in[I_POOLS] + l * BRW;
#pragma unroll
      for (int m = 0; m < 2; ++m)
#pragma unroll
          for (int n = 0; n < 4; ++n) { const int col = g * 128 + hf * 64 + n * 16 + 4 * fq; const f32x4 sc = *(const f32x4*)(ps + col);
              v2u o; o.x = pk2(acc[m][n].x * sc.x, acc[m][n].y * sc.y); o.y = pk2(acc[m][n].z * sc.z, acc[m][n].w * sc.w);
#if DBG_POOLY
              o = *(const LAS v2u*)(Yl + (m * 16 + fr) * 1040 + col * 2);
#endif
              *(v2u*)(BR + (size_t)(r0 + m * 16 + fr) * D + B_D + col) = o; } }
    __syncthreads();
}

DI void lru_item(Frame& F, int l, int item) {
    const int b = item >> 3, h = item & 7;
    const bf16* U = WSP(bf16, WS_U); bf16* BR = WSP(bf16, WS_BR); float* HF = WSP(float, WS_H);
    LAS float* XC = (LAS float*)F.lds;
    LAS float* A_ = (LAS float*)(F.lds + 34816);
    LAS float* B_ = (LAS float*)(F.lds + 69632);
    LAS float* CAR = (LAS float*)(F.lds + 104448);
    LAS float* CWL = (LAS float*)(F.lds + 108544);
    const int fr = F.lane & 15, fq = F.lane >> 4;
    if (F.tid < 320) CWL[F.tid] = (F.tid < 256) ? F.p->in[I_LCW][(size_t)l * 4 * BRW + (F.tid >> 6) * BRW + 64 * h + (F.tid & 63)] : F.p->in[I_LCB][l * BRW + 64 * h + (F.tid - 256)];
    __syncthreads();
    const bf16* WL = WSP(bf16, WS_SMALLW + SW_LRU);
    for (int d = 0; d < 2; ++d) {
        bf16x8 wf[2][4][2];
#pragma unroll
        for (int q = 0; q < 2; ++q)
#pragma unroll
            for (int n = 0; n < 4; ++n)
#pragma unroll
                for (int s = 0; s < 2; ++s) wf[q][n][s] = *(const bf16x8*)(WL + ((size_t)((d * 2 + q) * 8 + h) * 64 + n * 16 + fr) * 64 + s * 32 + 8 * fq);
        float ba[4], bx[4], sp[4];
#pragma unroll
        for (int n = 0; n < 4; ++n) { const int ch = 64 * h + n * 16 + fr;
            ba[n] = F.p->in[I_LBA][(l * 2 + d) * BRW + ch]; bx[n] = F.p->in[I_LBX][(l * 2 + d) * BRW + ch];
            const float lam = F.p->in[I_LLAM][(l * 2 + d) * BRW + ch]; sp[n] = (lam > 15.f) ? expf(-lam) : log1pf(expf(-lam)); }
        float Hc = 0.f;
        for (int seg = 0; seg < 2; ++seg) {
            const int L = seg ? SEQ : CTX, row0 = seg ? b * SEQ : TL + b * CTX;
            const bool wr_out = (seg == 1) || (l == 0);
            for (int cb = 0; cb < L; cb += 128) {
                { const int p = F.tid >> 2, cq = F.tid & 3, ti = d ? (L - 1 - (cb + p)) : (cb + p);
                  float xc[16];
#pragma unroll
                  for (int k = 0; k < 16; ++k) xc[k] = CWL[256 + 16 * cq + k];
#pragma unroll
                  for (int j = 0; j < 4; ++j) { const int tt = ti + j - 2;
                      if (tt >= 0 && tt < L) { const bf16* up = U + (size_t)(row0 + tt) * INC + U_RX + 64 * h + 16 * cq; const v4u u0 = *(const v4u*)up, u1 = *(const v4u*)(up + 8);
                          const LAS float* wj = CWL + j * 64 + 16 * cq;
                          xc[0] += wj[0] * bflo(u0.x); xc[1] += wj[1] * bfhi(u0.x); xc[2] += wj[2] * bflo(u0.y); xc[3] += wj[3] * bfhi(u0.y);
                          xc[4] += wj[4] * bflo(u0.z); xc[5] += wj[5] * bfhi(u0.z); xc[6] += wj[6] * bflo(u0.w); xc[7] += wj[7] * bfhi(u0.w);
                          xc[8] += wj[8] * bflo(u1.x); xc[9] += wj[9] * bfhi(u1.x); xc[10] += wj[10] * bflo(u1.y); xc[11] += wj[11] * bfhi(u1.y);
                          xc[12] += wj[12] * bflo(u1.z); xc[13] += wj[13] * bfhi(u1.z); xc[14] += wj[14] * bflo(u1.w); xc[15] += wj[15] * bfhi(u1.w); } }
#pragma unroll
                  for (int k = 0; k < 16; k += 4) *(LAS f32x4*)(XC + p * 68 + 16 * cq + k) = (f32x4){xc[k], xc[k + 1], xc[k + 2], xc[k + 3]}; }
                __syncthreads();
                { f32x4 da[4], dx[4];
#pragma unroll
                  for (int n = 0; n < 4; ++n) { da[n] = (f32x4){0.f, 0.f, 0.f, 0.f}; dx[n] = da[n]; }
#pragma unroll
                  for (int s = 0; s < 2; ++s) {
                      const LAS float* xp = XC + (16 * F.wave + fr) * 68 + s * 32 + 8 * fq;
                      const f32x4 x0 = *(const LAS f32x4*)xp, x1 = *(const LAS f32x4*)(xp + 4);
                      v4u pk; pk.x = pk2(x0.x, x0.y); pk.y = pk2(x0.z, x0.w); pk.z = pk2(x1.x, x1.y); pk.w = pk2(x1.z, x1.w);
                      const bf16x8 xa = __builtin_bit_cast(bf16x8, pk);
#pragma unroll
                      for (int n = 0; n < 4; ++n) { da[n] = __builtin_amdgcn_mfma_f32_16x16x32_bf16(xa, wf[0][n][s], da[n], 0, 0, 0); dx[n] = __builtin_amdgcn_mfma_f32_16x16x32_bf16(xa, wf[1][n][s], dx[n], 0, 0, 0); }
                  }
#pragma unroll
                  for (int n = 0; n < 4; ++n)
#pragma unroll
                      for (int rg = 0; rg < 4; ++rg) { const int p = 16 * F.wave + 4 * fq + rg, ch = n * 16 + fr;
                          const float xv = XC[p * 68 + ch];
                          const float r = 1.0f / (1.0f + expf(-(da[n][rg] + ba[n]))), ig = 1.0f / (1.0f + expf(-(dx[n][rg] + bx[n])));
                          const float la = -8.0f * r * sp[n];
                          A_[p * 68 + ch] = expf(la); B_[p * 68 + ch] = sqrtf(-expm1f(2.0f * la)) * ig * xv; } }
                LDS_WAIT();
                { float P = 1.f, hl = 0.f;
#pragma unroll
                  for (int q = 0; q < 16; ++q) { const int p = 16 * F.wave + q; const float a = A_[p * 68 + F.lane], bb = B_[p * 68 + F.lane]; hl = a * hl + bb; P *= a; }
                  CAR[(F.wave * 64 + F.lane) * 2] = P; CAR[(F.wave * 64 + F.lane) * 2 + 1] = hl; }
                __syncthreads();
                float cin = Hc;
                { float c = Hc;
#pragma unroll
                  for (int w = 0; w < 8; ++w) { if (w == F.wave) cin = c; c = CAR[(w * 64 + F.lane) * 2] * c + CAR[(w * 64 + F.lane) * 2 + 1]; }
                  Hc = c; }
                { float hh = cin;
#pragma unroll 4
                  for (int q = 0; q < 16; ++q) { const int p = 16 * F.wave + q; hh = A_[p * 68 + F.lane] * hh + B_[p * 68 + F.lane];
                      const int ti = d ? (L - 1 - (cb + p)) : (cb + p); const size_t row = (size_t)(row0 + ti);
                      if (wr_out) {
                          if (d == 0) HF[row * BRW + 64 * h + F.lane] = hh;
                          else { const float hf = HF[row * BRW + 64 * h + F.lane]; const float rg = bf2f(U[row * INC + U_RG + 64 * h + F.lane]);
                                 BR[row * D + B_B + 64 * h + F.lane] = (bf16)f2bf((hf + hh) * gelu_tanh(rg)); } } } }
                __syncthreads();
            }
        }
        VM_WAIT(); __syncthreads();
    }
}

DI void attn_task(Frame& F, int l, int ta, LAS float* wl) {
    const bf16* U = WSP(bf16, WS_U); bf16* BR = WSP(bf16, WS_BR);
    const int qrow = ta >> 1, kvh = ta & 1;
    const bool lat = qrow < TL;
    const int b = lat ? qrow / SEQ : (qrow - TL) / CTX, t = lat ? qrow % SEQ : 0;
    LAS float* qs = wl;
    LAS float* pp = wl + 256;
#pragma unroll
    for (int g = 0; g < 4; ++g) qs[g * 64 + F.lane] = bf2f(U[(size_t)qrow * INC + U_Q + (kvh * 4 + g) * 64 + F.lane]);
    LDS_WAIT();
    float m0 = -1e30f, m1 = -1e30f, m2 = -1e30f, m3 = -1e30f;
#pragma unroll 1
    for (int rr = 0; rr < 9; ++rr) {
        const int ki = rr * 64 + F.lane; bool valid; size_t krow;
        if (ki < 256) { valid = true; krow = (size_t)(TL + b * CTX + ki); }
        else { const int s = t - 128 + (ki - 256); valid = lat && (ki - 256 <= 256) && s >= 0 && s < SEQ; krow = (size_t)(b * SEQ + (valid ? s : 0)); }
        float d0 = 0.f, d1 = 0.f, d2 = 0.f, d3 = 0.f;
        if (valid) {
            const bf16* kp = U + krow * INC + U_K + kvh * 64;
#pragma unroll
            for (int c8 = 0; c8 < 8; ++c8) { const v4u kv = *(const v4u*)(kp + 8 * c8);
                const float kf[8] = {bflo(kv.x), bfhi(kv.x), bflo(kv.y), bfhi(kv.y), bflo(kv.z), bfhi(kv.z), bflo(kv.w), bfhi(kv.w)};
#pragma unroll
                for (int hq = 0; hq < 2; ++hq) { const f32x4 q0 = *(const LAS f32x4*)(qs + 0 * 64 + 8 * c8 + 4 * hq), q1 = *(const LAS f32x4*)(qs + 1 * 64 + 8 * c8 + 4 * hq), q2 = *(const LAS f32x4*)(qs + 2 * 64 + 8 * c8 + 4 * hq), q3 = *(const LAS f32x4*)(qs + 3 * 64 + 8 * c8 + 4 * hq);
                    const float k0 = kf[4 * hq], k1 = kf[4 * hq + 1], k2 = kf[4 * hq + 2], k3 = kf[4 * hq + 3];
                    d0 += q0.x * k0 + q0.y * k1 + q0.z * k2 + q0.w * k3; d1 += q1.x * k0 + q1.y * k1 + q1.z * k2 + q1.w * k3;
                    d2 += q2.x * k0 + q2.y * k1 + q2.z * k2 + q2.w * k3; d3 += q3.x * k0 + q3.y * k1 + q3.z * k2 + q3.w * k3; } }
        }
        const f32x4 sv = valid ? (f32x4){d0 * 0.125f, d1 * 0.125f, d2 * 0.125f, d3 * 0.125f} : (f32x4){-1e30f, -1e30f, -1e30f, -1e30f};
        m0 = fmaxf(m0, sv.x); m1 = fmaxf(m1, sv.y); m2 = fmaxf(m2, sv.z); m3 = fmaxf(m3, sv.w);
        *(LAS f32x4*)(pp + ki * 4) = sv;
    }
    const float* sinkp = F.p->in[I_SINK] + l * 8 + kvh * 4;
    const float k0s = sinkp[0], k1s = sinkp[1], k2s = sinkp[2], k3s = sinkp[3];
    m0 = fmaxf(wave_max(m0), k0s); m1 = fmaxf(wave_max(m1), k1s); m2 = fmaxf(wave_max(m2), k2s); m3 = fmaxf(wave_max(m3), k3s);
    float s0 = 0.f, s1 = 0.f, s2 = 0.f, s3 = 0.f;
    LDS_WAIT();
#pragma unroll 1
    for (int rr = 0; rr < 9; ++rr) {
        const int ki = rr * 64 + F.lane; f32x4 sv = *(const LAS f32x4*)(pp + ki * 4);
        sv.x = (sv.x > -1e29f) ? __expf(sv.x - m0) : 0.f; sv.y = (sv.y > -1e29f) ? __expf(sv.y - m1) : 0.f; sv.z = (sv.z > -1e29f) ? __expf(sv.z - m2) : 0.f; sv.w = (sv.w > -1e29f) ? __expf(sv.w - m3) : 0.f;
        s0 += sv.x; s1 += sv.y; s2 += sv.z; s3 += sv.w;
        *(LAS f32x4*)(pp + ki * 4) = sv;
    }
    const float ri0 = 1.0f / (wave_sum(s0) + __expf(k0s - m0)), ri1 = 1.0f / (wave_sum(s1) + __expf(k1s - m1)), ri2 = 1.0f / (wave_sum(s2) + __expf(k2s - m2)), ri3 = 1.0f / (wave_sum(s3) + __expf(k3s - m3));
    LDS_WAIT();
    float o0 = 0.f, o1 = 0.f, o2 = 0.f, o3 = 0.f;
    { const bf16* vp = U + (size_t)(TL + b * CTX) * INC + U_V + kvh * 64 + F.lane;
#pragma unroll 4
      for (int ki = 0; ki < 256; ++ki) { const f32x4 p4 = *(const LAS f32x4*)(pp + ki * 4); const float v = bf2f(vp[(size_t)ki * INC]); o0 += p4.x * v; o1 += p4.y * v; o2 += p4.z * v; o3 += p4.w * v; } }
    if (lat) { const int slo = max(t - 128, 0), shi = min(t + 128, SEQ - 1);
        const bf16* vp = U + (size_t)(b * SEQ) * INC + U_V + kvh * 64 + F.lane;
#pragma unroll 4
        for (int s = slo; s <= shi; ++s) { const f32x4 p4 = *(const LAS f32x4*)(pp + (256 + s - t + 128) * 4); const float v = bf2f(vp[(size_t)s * INC]); o0 += p4.x * v; o1 += p4.y * v; o2 += p4.z * v; o3 += p4.w * v; } }
    bf16* op = BR + (size_t)qrow * D + B_C + (kvh * 4) * 64 + F.lane;
    op[0] = (bf16)f2bf(o0 * ri0); op[64] = (bf16)f2bf(o1 * ri1); op[128] = (bf16)f2bf(o2 * ri2); op[192] = (bf16)f2bf(o3 * ri3);
    LDS_WAIT();
}

DI void mixer_phase(Frame& F, int l) {
    const int nrow_out = (l == 0) ? MT : TL;
    const int nA = nrow_out * 2 / 64, nC = nrow_out / 32, nP = nrow_out / 32;
    const int total = 64 + nA + nC + nP;
    LAS int* qslot = (LAS int*)(F.lds + LC_SCR);
    for (;;) {
        if (F.tid == 0) qslot[0] = (int)__hip_atomic_fetch_add(F.ctl + CW_QUEUE + l * 64, 1u, __ATOMIC_RELAXED, __HIP_MEMORY_SCOPE_AGENT);
        __syncthreads();
        const int it = qslot[0];
        __syncthreads();
        if (it >= total) break;
        F.lane = lane_id_asm(); F.tid = F.wave * 64 + F.lane;
        if (it < 64) lru_item(F, l, it);
        else if (it < 64 + nA) { LAS float* wl = (LAS float*)(F.lds + F.wave * 10240); const int t0 = (it - 64) * 64 + F.wave * 8;
            for (int i = 0; i < 8; ++i) attn_task(F, l, t0 + i, wl); }
        else if (it < 64 + nA + nC) conv_unit(F, l, it - 64 - nA);
        else pool_unit(F, l, it - 64 - nA - nC);
        __syncthreads();
    }
}

DI int xcd_remap(int L, int total) { const int q = total / 8, r = total % 8, x = L % 8, off = L / 8; return (x < r ? x * (q + 1) : r * (q + 1) + (x - r) * q) + off; }
typedef __bf16 bf16x2_t __attribute__((ext_vector_type(2)));
DI unsigned cvt_pk_bf16(float lo, float hi) { const f32x2 v = {lo, hi}; const bf16x2_t b = __builtin_convertvector(v, bf16x2_t); return __builtin_bit_cast(unsigned, b); }
typedef f32x4 AccT[2][2][4][2];

struct SchedP2 {
    int G, c, nMmain, nmain, total; const char* A; const char* B;
    DI bool next(int i, Unit& u) const {
        const int L = i * G + c; if (L >= total) return false;
        int pm, pn;
        if (L < nmain) pg8::tile_of(L, nMmain, N2 / 256, pm, pn); else { const int r = L - nmain; pm = 128 + r / 3; pn = r % 3; }
        u.a = A + (size_t)pm * 256 * (D * 2); u.b = B + (size_t)pn * 256 * (D * 2); u.rows = nullptr; u.nvalid = 0; u.i0 = pm; u.i1 = pn; u.i2 = 0; u.i3 = 0; return true;
    }
};
struct EpiUG {
    static constexpr bool PERM = true;
    bf16* U; bf16* Gt; const float* bgate; unsigned* cs;
    DI bool operator()(AccT& acc, const Unit& u, int wr, int wc, int fr, int fq) const {
        const int row0 = u.i0 * 256 + wr * 64 + fr, pn = u.i1; unsigned hsh = 0;
        if (pn < INC / 256) {
            bf16* base = U + pn * 256 + wc * 32 + 8 * fq;
#pragma unroll
            for (int ai = 0; ai < 2; ++ai)
#pragma unroll
                for (int m = 0; m < 4; ++m) { bf16* rowp = base + (size_t)(row0 + ai * 128 + m * 16) * INC;
#pragma unroll
                    for (int bj = 0; bj < 2; ++bj) { const f32x4 v0 = acc[ai][bj][m][0], v1 = acc[ai][bj][m][1];
                        v4u w; w.x = cvt_pk_bf16(v0[0], v0[1]); w.y = cvt_pk_bf16(v0[2], v0[3]); w.z = cvt_pk_bf16(v1[0], v1[1]); w.w = cvt_pk_bf16(v1[2], v1[3]);
                        *(v4u*)(rowp + bj * 128) = w; hsh += (w.x * 3u + w.y * 5u + w.z * 7u + w.w * 11u) * (unsigned)(row0 + ai * 128 + m * 16 + 131 * pn + 7 * bj + 1); } }
        } else {
            const int colt = (pn - INC / 256) * 256 + wc * 32 + 8 * fq;
            f32x4 bv[2][2];
#pragma unroll
            for (int bj = 0; bj < 2; ++bj)
#pragma unroll
                for (int n = 0; n < 2; ++n) bv[bj][n] = *(const f32x4*)(bgate + colt + bj * 128 + 4 * n);
#pragma unroll
            for (int ai = 0; ai < 2; ++ai)
#pragma unroll
                for (int m = 0; m < 4; ++m) { bf16* rowp = Gt + (size_t)(row0 + ai * 128 + m * 16) * NGATE + colt;
#pragma unroll
                    for (int bj = 0; bj < 2; ++bj) { f32x4 v0 = acc[ai][bj][m][0] + bv[bj][0], v1 = acc[ai][bj][m][1] + bv[bj][1];
#pragma unroll
                        for (int k = 0; k < 4; ++k) { v0[k] = __builtin_amdgcn_rcpf(1.0f + __expf(-v0[k])); v1[k] = __builtin_amdgcn_rcpf(1.0f + __expf(-v1[k])); }
                        v4u w; w.x = cvt_pk_bf16(v0[0], v0[1]); w.y = cvt_pk_bf16(v0[2], v0[3]); w.z = cvt_pk_bf16(v1[0], v1[1]); w.w = cvt_pk_bf16(v1[2], v1[3]);
                        *(v4u*)(rowp + bj * 128) = w; hsh += (w.x * 3u + w.y * 5u + w.z * 7u + w.w * 11u) * (unsigned)(row0 + ai * 128 + m * 16 + 131 * pn + 7 * bj + 1); } }
        }
        if (cs) { for (int o = 1; o < 64; o <<= 1) hsh += __shfl_xor(hsh, o); if ((fr | fq) == 0) __hip_atomic_fetch_add(cs + (pn < INC / 256 ? 0 : 128), hsh, __ATOMIC_RELAXED, __HIP_MEMORY_SCOPE_AGENT); }
        return false;
    }
};

struct SchedP4 {
    int G, c, nM, ntiles; const char* A; const char* B;
    DI bool next(int i, Unit& u) const {
        const int j = i >> 2, kb = i & 3, L = j * G + c; if (L >= ntiles) return false;
        int pm, pn; pg8::tile_of(L, nM, 8, pm, pn);
        u.a = A + (size_t)pm * 256 * (D * 2) + kb * (BRW * 2); u.b = B + ((size_t)kb * D + pn * 256) * (BRW * 2); u.rows = nullptr; u.nvalid = 0; u.i0 = pm; u.i1 = pn; u.i2 = kb; u.i3 = 0; return true;
    }
};
struct EpiHorner {
    static constexpr bool PERM = true;
    const bf16* Gt; bf16* ACC;
    DI bool operator()(AccT& acc, const Unit& u, int wr, int wc, int fr, int fq) const {
        const int row0 = u.i0 * 256 + wr * 64 + fr, col0 = u.i1 * 256 + wc * 32 + 8 * fq, kb = u.i2;
#pragma unroll
        for (int ai = 0; ai < 2; ++ai)
#pragma unroll
            for (int m = 0; m < 4; ++m) { const size_t row = (size_t)(row0 + ai * 128 + m * 16);
#pragma unroll
                for (int bj = 0; bj < 2; ++bj) {
                    const v4u g0 = *(const v4u*)(Gt + row * NGATE + kb * D + col0 + bj * 128);
                    float s[8] = {bflo(g0.x), bfhi(g0.x), bflo(g0.y), bfhi(g0.y), bflo(g0.z), bfhi(g0.z), bflo(g0.w), bfhi(g0.w)};
#pragma unroll
                    for (int k = 0; k < 8; ++k) s[k] = fmaxf(s[k], 1e-10f);
                    if (kb < 3) {
                        const v4u g1 = *(const v4u*)(Gt + row * NGATE + (kb + 1) * D + col0 + bj * 128);
                        const float t[8] = {bflo(g1.x), bfhi(g1.x), bflo(g1.y), bfhi(g1.y), bflo(g1.z), bfhi(g1.z), bflo(g1.w), bfhi(g1.w)};
#pragma unroll
                        for (int k = 0; k < 8; ++k) s[k] *= __builtin_amdgcn_rcpf(fmaxf(t[k], 1e-10f));
                    }
                    f32x4 v0 = acc[ai][bj][m][0], v1 = acc[ai][bj][m][1];
                    v0[0] *= s[0]; v0[1] *= s[1]; v0[2] *= s[2]; v0[3] *= s[3]; v1[0] *= s[4]; v1[1] *= s[5]; v1[2] *= s[6]; v1[3] *= s[7];
                    acc[ai][bj][m][0] = v0; acc[ai][bj][m][1] = v1;
                    if (kb == 3) { v4u w; w.x = cvt_pk_bf16(v0[0], v0[1]); w.y = cvt_pk_bf16(v0[2], v0[3]); w.z = cvt_pk_bf16(v1[0], v1[1]); w.w = cvt_pk_bf16(v1[2], v1[3]);
                        *(v4u*)(ACC + row * D + col0 + bj * 128) = w; }
                } }
        return kb < 3;
    }
};

struct SchedP5 {
    int G, c, nM, ntiles; const char* A; const char* B;
    DI bool next(int i, Unit& u) const {
        const int L = i * G + c; if (L >= ntiles) return false;
        int pm, pn; pg8::tile_of(L, nM, 8, pm, pn);
        u.a = A + (size_t)pm * 256 * (D * 2); u.b = B + (size_t)pn * 256 * (D * 2); u.rows = nullptr; u.nvalid = 0; u.i0 = pm; u.i1 = pn; u.i2 = 0; u.i3 = 0; return true;
    }
};
struct EpiRes {
    static constexpr bool PERM = false;
    const float* xl; const float* xc; float* ol; float* oc; const float* modg;
    DI bool operator()(AccT& acc, const Unit& u, int wr, int wc, int fr, int fq) const {
        const int pm = u.i0; const bool lat = pm < 128; const int bidx = lat ? pm / 16 : 8;
        const float* src = lat ? xl + (size_t)pm * 256 * D : xc + (size_t)(pm - 128) * 256 * D;
        float* dst = lat ? ol + (size_t)pm * 256 * D : oc + (size_t)(pm - 128) * 256 * D;
        const int col0 = u.i1 * 256 + wc * 32 + 4 * fq, r0 = wr * 64 + fr;
        const float* g1 = modg + (size_t)bidx * MODW;
        f32x4 gv[2][2];
#pragma unroll
        for (int bj = 0; bj < 2; ++bj)
#pragma unroll
            for (int n = 0; n < 2; ++n) gv[bj][n] = *(const f32x4*)(g1 + col0 + bj * 128 + n * 16);
#pragma unroll
        for (int ai = 0; ai < 2; ++ai)
#pragma unroll
            for (int m = 0; m < 4; ++m) { const size_t off = (size_t)(r0 + ai * 128 + m * 16) * D + col0;
#pragma unroll
                for (int bj = 0; bj < 2; ++bj)
#pragma unroll
                    for (int n = 0; n < 2; ++n) { const f32x4 bs = *(const f32x4*)(src + off + bj * 128 + n * 16); *(f32x4*)(dst + off + bj * 128 + n * 16) = bs + gv[bj][n] * acc[ai][bj][m][n]; }
                if (m & 1) asm volatile("" ::: "memory"); }
        return false;
    }
};

struct SchedMoe {
    int G, c, NT, mode; const LAS int* tpre; const LAS int* cnt;
    const char* A; const char* B; const int* rowlist;
    DI bool next(int i, Unit& u) const {
        const int L0 = i * G + c; if (L0 >= NT * 8) return false;
        const int L = xcd_remap(L0, NT * 8);
        const int rt = L >> 3, ct = L & 7; int e = 0;
#pragma unroll
        for (int k = 1; k < NE; ++k) e += (tpre[k] <= rt) ? 1 : 0;
        e = __builtin_amdgcn_readfirstlane(e);
        const int rb = __builtin_amdgcn_readfirstlane(rt - tpre[e]);
        u.nvalid = __builtin_amdgcn_readfirstlane(min(256, cnt[e] - rb * 256)); u.rows = rowlist + (size_t)e * ECAP + rb * 256;
        if (mode == 0) { u.a = A; u.b = B + ((size_t)e * 2048 + ct * 256) * (D * 2); }
        else { u.a = A + (size_t)rt * 256 * (DE * 2); u.b = B + ((size_t)e * 2048 + ct * 256) * (DE * 2); }
        u.i0 = rt; u.i1 = ct; u.i2 = e; u.i3 = rb; return true;
    }
};
struct EpiSwiglu {
    static constexpr bool PERM = true;
    bf16* HB;
    DI bool operator()(AccT& acc, const Unit& u, int wr, int wc, int fr, int fq) const {
        const int row0 = u.i0 * 256 + wr * 64 + fr, col0 = u.i1 * 128 + wc * 32 + 8 * fq;
#pragma unroll
        for (int ai = 0; ai < 2; ++ai)
#pragma unroll
            for (int m = 0; m < 4; ++m) {
                f32x4 g0 = acc[ai][0][m][0], g1 = acc[ai][0][m][1]; const f32x4 u0 = acc[ai][1][m][0], u1 = acc[ai][1][m][1];
#pragma unroll
                for (int k = 0; k < 4; ++k) { g0[k] = g0[k] * __builtin_amdgcn_rcpf(1.0f + __expf(-g0[k])) * u0[k]; g1[k] = g1[k] * __builtin_amdgcn_rcpf(1.0f + __expf(-g1[k])) * u1[k]; }
                v4u w; w.x = cvt_pk_bf16(g0[0], g0[1]); w.y = cvt_pk_bf16(g0[2], g0[3]); w.z = cvt_pk_bf16(g1[0], g1[1]); w.w = cvt_pk_bf16(g1[2], g1[3]);
                *(v4u*)(HB + (size_t)(row0 + ai * 128 + m * 16) * DE + col0) = w; }
        return false;
    }
};
struct EpiDown {
    static constexpr bool PERM = true;
    bf16* O; const float* wlist;
    DI bool operator()(AccT& acc, const Unit& u, int wr, int wc, int fr, int fq) const {
        const int rl0 = wr * 64 + fr, col0 = u.i1 * 256 + wc * 32 + 8 * fq;
        const float* wp = wlist + (size_t)u.i2 * ECAP + u.i3 * 256;
#pragma unroll
        for (int ai = 0; ai < 2; ++ai)
#pragma unroll
            for (int m = 0; m < 4; ++m) { const int rl = rl0 + ai * 128 + m * 16; const float w = rl < u.nvalid ? wp[rl] : 0.f;
                bf16* rowp = O + (size_t)(u.i0 * 256 + rl) * D + col0;
#pragma unroll
                for (int bj = 0; bj < 2; ++bj) { const f32x4 v0 = acc[ai][bj][m][0] * w, v1 = acc[ai][bj][m][1] * w;
                    v4u q; q.x = cvt_pk_bf16(v0[0], v0[1]); q.y = cvt_pk_bf16(v0[2], v0[3]); q.z = cvt_pk_bf16(v1[0], v1[1]); q.w = cvt_pk_bf16(v1[2], v1[3]);
                    *(v4u*)(rowp + bj * 128) = q; } }
        return false;
    }
};


DI void dbg_checksum(Frame& F, const unsigned* p, size_t nwords, unsigned* cs) {
    unsigned h = 0;
    for (size_t i = (size_t)F.bid * 512 + F.tid; i < nwords; i += (size_t)F.G * 512) h += p[i] * 2654435761u + (unsigned)i;
    __hip_atomic_fetch_add(cs, h, __ATOMIC_RELAXED, __HIP_MEMORY_SCOPE_AGENT);
}
constexpr int NPH = 20;
__global__ void __launch_bounds__(512, 2) mk_fwd(Params prm) {
    extern __shared__ __attribute__((aligned(16))) unsigned char lds_raw[];
    Frame F;
    F.lds = (LAS unsigned char*)lds_raw; F.p = &prm; F.ws = prm.ws; F.ctl = (unsigned*)(prm.ws + WS_CTL);
    F.tid = threadIdx.x; F.lane = F.tid & 63; F.wave = __builtin_amdgcn_readfirstlane(F.tid >> 6); F.G = gridDim.x; F.bid = blockIdx.x;
    for (int u = F.tid; u < (LDS_BYTES - LDSCTL_OFF) / 4; u += 512) ((LAS unsigned*)(F.lds + LDSCTL_OFF))[u] = 0u;
    __syncthreads();
#if MK_PER_PHASE
#define GRID_BAR() do { } while (0)
#else
    XcdBarrier bar = xcd_barrier_post(F.ctl + CW_BAR, (volatile LAS unsigned*)(F.lds + LDSCTL_OFF));
#define GRID_BAR() xcd_barrier(bar)
#endif
    const int lo = prm.ph_lo, hi = prm.ph_hi;
#define IN(k) (lo <= (k) && (k) < hi)
#define PB() do { F.lane = lane_id_asm(); F.tid = F.wave * 64 + F.lane; } while (0)
#define SEAM(k) do { if (IN(k) && IN((k) + 1)) GRID_BAR(); } while (0)
    LAS unsigned char* ring = F.lds;
    const float* mod = WSP(float, WS_MOD);

    if (IN(0)) { PB(); mod_gemv(F); PB(); convert_weights(F, 0); }
    SEAM(0);
    for (int l = 0; l < DEPTH; ++l) {
        const int pb = 1 + 9 * l;
        if (IN(pb + 0)) { PB(); norm_phase(F, l, l == 0 ? 0 : 1); PB(); if (l > 0) convert_weights(F, l); }
        SEAM(pb + 0);
        if (IN(pb + 1)) {
            SchedP2 S; S.G = F.G; S.c = F.bid; S.nMmain = (l == 0) ? 136 : 128; S.nmain = S.nMmain * (N2 / 256); S.total = S.nmain + ((l == 0) ? 0 : 24);
            S.A = (const char*)WSP(bf16, WS_H); S.B = (const char*)WSP(bf16, WS_W2);
            EpiUG E; E.U = WSP(bf16, WS_U); E.Gt = WSP(bf16, WS_G); E.bgate = F.p->in[I_BGATE] + (size_t)l * NGATE; E.cs = (DBG_TWICE && l == 0) ? F.ctl + 31000 : nullptr;
            pg8::GEMM_PHASE<EpiUG, SchedP2, false>(ring, F.wave, D, D * 2, D * 2, S, E);
        }
        SEAM(pb + 1);
#if DBG_TWICE
        if (l == 0 && hi == 3) {
            GRID_BAR();
            PB(); dbg_checksum(F, (const unsigned*)WSP(bf16, WS_H), (size_t)MT * D / 2, F.ctl + 30384); dbg_checksum(F, (const unsigned*)WSP(bf16, WS_W2), (size_t)N2 * D / 2, F.ctl + 30448);
            dbg_checksum(F, (const unsigned*)WSP(bf16, WS_U), (size_t)MT * INC / 2, F.ctl + 30000); dbg_checksum(F, (const unsigned*)WSP(bf16, WS_G), (size_t)MT * NGATE / 2, F.ctl + 30064);
            GRID_BAR();
            {
                SchedP2 S; S.G = F.G; S.c = F.bid; S.nMmain = 136; S.nmain = S.nMmain * (N2 / 256); S.total = S.nmain;
                S.A = (const char*)WSP(bf16, WS_H); S.B = (const char*)WSP(bf16, WS_W2);
                EpiUG E; E.U = WSP(bf16, WS_U); E.Gt = WSP(bf16, WS_G); E.bgate = F.p->in[I_BGATE]; E.cs = F.ctl + 31300;
                pg8::GEMM_PHASE<EpiUG, SchedP2, false>(ring, F.wave, D, D * 2, D * 2, S, E);
            }
            GRID_BAR();
            PB(); dbg_checksum(F, (const unsigned*)WSP(bf16, WS_H), (size_t)MT * D / 2, F.ctl + 30512); dbg_checksum(F, (const unsigned*)WSP(bf16, WS_W2), (size_t)N2 * D / 2, F.ctl + 30576);
            dbg_checksum(F, (const unsigned*)WSP(bf16, WS_U), (size_t)MT * INC / 2, F.ctl + 30128); dbg_checksum(F, (const unsigned*)WSP(bf16, WS_G), (size_t)MT * NGATE / 2, F.ctl + 30192);
            GRID_BAR();
            const unsigned a0 = __hip_atomic_load(F.ctl + 30000, __ATOMIC_RELAXED, __HIP_MEMORY_SCOPE_AGENT), a1 = __hip_atomic_load(F.ctl + 30064, __ATOMIC_RELAXED, __HIP_MEMORY_SCOPE_AGENT);
            const unsigned b0 = __hip_atomic_load(F.ctl + 30128, __ATOMIC_RELAXED, __HIP_MEMORY_SCOPE_AGENT), b1 = __hip_atomic_load(F.ctl + 30192, __ATOMIC_RELAXED, __HIP_MEMORY_SCOPE_AGENT);
#define LDW(k) __hip_atomic_load(F.ctl + (k), __ATOMIC_RELAXED, __HIP_MEMORY_SCOPE_AGENT)
            int code = 0;
            if (a0 != b0) code |= 1; if (a1 != b1) code |= 2;
            if (LDW(31000) != LDW(31300)) code |= 4; if (LDW(31128) != LDW(31428)) code |= 8;
            const float val = (float)(1 + code);
            for (size_t i = (size_t)F.bid * 512 + F.tid; i < (size_t)TL * D; i += (size_t)F.G * 512) F.p->out[i] = val;
        }
#endif
        if (IN(pb + 2)) { PB(); qk_prep(F, l); }
        SEAM(pb + 2);
        if (IN(pb + 3)) { PB(); mixer_phase(F, l); }
        SEAM(pb + 3);
#if DBG_DUMP == 3
        if (l == 0 && hi == 5) {
            GRID_BAR();
            const bf16* br = WSP(bf16, WS_BR);
            for (size_t i = (size_t)F.bid * 512 + F.tid; i < (size_t)TL * D; i += (size_t)F.G * 512) { const size_t row = i >> 9; const int c = (int)(i & 511);
                F.p->out[i] = (i < 196608) ? bf2f(WSP(bf16, WS_SMALLW)[i]) : 0.f; }
        }
#endif
        const int nM = (l == 0) ? 136 : 128;
        if (IN(pb + 4)) {
            SchedP4 S; S.G = F.G; S.c = F.bid; S.nM = nM; S.ntiles = nM * 8; S.A = (const char*)WSP(bf16, WS_BR); S.B = (const char*)WSP(bf16, WS_WB);
            EpiHorner E; E.Gt = WSP(bf16, WS_G); E.ACC = WSP(bf16, WS_U);
            pg8::GEMM_PHASE<EpiHorner, SchedP4, false>(ring, F.wave, BRW, D * 2, BRW * 2, S, E);
        }
        SEAM(pb + 4);
        if (IN(pb + 5)) {
            SchedP5 S; S.G = F.G; S.c = F.bid; S.nM = nM; S.ntiles = nM * 8; S.A = (const char*)WSP(bf16, WS_U); S.B = (const char*)WSP(bf16, WS_WO);
            EpiRes E; E.xl = (l == 0) ? F.p->in[I_X] : F.p->out; E.xc = (l == 0) ? F.p->in[I_CTX] : WSP(float, WS_XC); E.ol = F.p->out; E.oc = WSP(float, WS_XC); E.modg = mod + (size_t)l * 9 * MODW + MO_G1;
            pg8::GEMM_PHASE<EpiRes, SchedP5, false>(ring, F.wave, D, D * 2, D * 2, S, E);
        }
        SEAM(pb + 5);
        if (IN(pb + 6)) { PB(); router_phase(F, l); }
        SEAM(pb + 6);
        if (IN(pb + 7) || IN(pb + 8)) {
            LAS int* tpre = (LAS int*)(F.lds + LC_SCR + 4096); LAS int* cn = tpre + 32;
            if (F.tid == 0) { int acc = 0; for (int e = 0; e < NE; ++e) { const int c = (int)__hip_atomic_load(F.ctl + CW_CNT + (l * 16 + e) * 64, __ATOMIC_RELAXED, __HIP_MEMORY_SCOPE_AGENT); cn[e] = c; tpre[e] = acc; acc += (c + 255) >> 8; } tpre[NE] = acc; }
            __syncthreads();
            SchedMoe S; S.G = F.G; S.c = F.bid; S.NT = __builtin_amdgcn_readfirstlane(tpre[NE]); S.tpre = tpre; S.cnt = cn; S.rowlist = (const int*)(F.ws + WS_LIST + LIST_ROW);
            if (IN(pb + 7)) {
                S.mode = 0; S.A = (const char*)WSP(bf16, WS_H); S.B = (const char*)WSP(bf16, WS_WGU);
                EpiSwiglu E; E.HB = WSP(bf16, WS_HB);
                pg8::GEMM_PHASE<EpiSwiglu, SchedMoe, true>(ring, F.wave, D, D * 2, D * 2, S, E);
            }
            SEAM(pb + 7);
            if (IN(pb + 8)) {
                S.mode = 1; S.A = (const char*)WSP(bf16, WS_HB); S.B = (const char*)WSP(bf16, WS_WD);
                EpiDown E; E.O = WSP(bf16, WS_O); E.wlist = (const float*)(F.ws + WS_LIST + LIST_W);
                pg8::GEMM_PHASE<EpiDown, SchedMoe, false>(ring, F.wave, DE, DE * 2, DE * 2, S, E);
            }
        }
        SEAM(pb + 8);
    }
    if (IN(NPH - 1)) { PB(); norm_phase(F, DEPTH - 1, 2); }
}

#ifndef DBG_DUMP
#endif
__global__ void dbg_dump(const bf16* a, const bf16* b, float* o, size_t n) {
    for (size_t i = (size_t)blockIdx.x * blockDim.x + threadIdx.x; i < n; i += (size_t)gridDim.x * blockDim.x) o[i] = bf2f(a[i]) + 3.0f * bf2f(b[i]);
}
__global__ void dbg_dump2(const bf16* br, int c0, int c1, float* o, size_t n) {
    for (size_t i = (size_t)blockIdx.x * blockDim.x + threadIdx.x; i < n; i += (size_t)gridDim.x * blockDim.x) { const size_t row = i >> 9; const int c = (int)(i & 511);
        o[i] = (row < (size_t)MT) ? bf2f(br[row * D + c0 + c]) + 3.0f * bf2f(br[row * D + c1 + c]) : 0.f; }
}
extern "C" void kernel_launch(void* const* d_in, const int* in_sizes, int n_in, void* d_out, int out_size, void* d_ws, size_t ws_size, hipStream_t stream) {
    static int grid = 0;
    if (grid == 0) {
        if (n_in != 34 || out_size != TL * D || ws_size < WS_END) { fprintf(stderr, "kernel_launch: unexpected shapes (n_in %d out %d ws %zu, need ws >= %zu)\n", n_in, out_size, ws_size, (size_t)WS_END); grid = -1; return; }
        int dev = 0, cus = 0, per_cu = 0;
        if (hipGetDevice(&dev) != hipSuccess || hipDeviceGetAttribute(&cus, hipDeviceAttributeMultiprocessorCount, dev) != hipSuccess) { grid = -1; return; }
        if (hipFuncSetAttribute((const void*)mk_fwd, hipFuncAttributeMaxDynamicSharedMemorySize, LDS_BYTES) != hipSuccess) { fprintf(stderr, "kernel_launch: hipFuncSetAttribute failed\n"); grid = -1; return; }
        if (hipOccupancyMaxActiveBlocksPerMultiprocessor(&per_cu, (const void*)mk_fwd, 512, LDS_BYTES) != hipSuccess || per_cu < 1) fprintf(stderr, "kernel_launch: occupancy query says %d\n", per_cu);
        (void)hipGetLastError();
        grid = cus;
        if (grid != 256) { fprintf(stderr, "kernel_launch: built for 256 CUs, device has %d\n", cus); grid = -1; return; }
    }
    if (grid < 0) return;
    (void)hipMemsetAsync((char*)d_ws + WS_CTL, 0, CTL_BYTES, stream);
    Params p{};
    for (int i = 0; i < 34; ++i) p.in[i] = (const float*)d_in[i];
    p.out = (float*)d_out; p.ws = (unsigned char*)d_ws;
#if MK_PER_PHASE
    for (int ph = 0; ph < DBG_PH_HI; ++ph) { p.ph_lo = ph; p.ph_hi = ph + 1; hipLaunchKernelGGL(mk_fwd, dim3(grid), dim3(512), LDS_BYTES, stream, p); }
#if DBG_DUMP == 1
    hipLaunchKernelGGL(dbg_dump, dim3(2048), dim3(256), 0, stream, (const bf16*)((char*)d_ws + WS_U), (const bf16*)((char*)d_ws + WS_G), (float*)d_out, (size_t)TL * D);
#endif
#else
    p.ph_lo = 0; p.ph_hi = DBG_PH_HI;
    hipLaunchKernelGGL(mk_fwd, dim3(grid), dim3(512), LDS_BYTES, stream, p);
#if DBG_DUMP == 1
    hipLaunchKernelGGL(dbg_dump, dim3(2048), dim3(256), 0, stream, (const bf16*)((char*)d_ws + WS_G), (const bf16*)((char*)d_ws + WS_U), (float*)d_out, (size_t)TL * D);
#endif
#if DBG_DUMP == 2
    hipLaunchKernelGGL(dbg_dump2, dim3(2048), dim3(256), 0, stream, (const bf16*)((char*)d_ws + WS_BR), DBG_BRSEL ? B_D : B_A, DBG_BRSEL ? B_D : B_B, (float*)d_out, (size_t)TL * D);
#endif
#endif
}
```

```cpp
#include <hip/hip_runtime.h>
#include <cstdio>
#include <cstdint>

#define DBG_DUMP 0
#ifndef G_U8
#define G_U8 1
#endif
#ifndef PROBE_MX
#define PROBE_MX 0
#endif
#ifndef PROBE_CV
#define PROBE_CV 0
#endif
#ifndef PROBE_RT
#define PROBE_RT 0
#endif
#ifndef F8_G
#define F8_G 0
#endif
#ifndef F8_WIN
#define F8_WIN 0
#endif
#ifndef F8_WOUT
#define F8_WOUT 0
#endif
#ifndef PROBE_LRU
#define PROBE_LRU 0
#endif
#ifndef PROBE_MIX
#define PROBE_MIX 0
#endif
#ifndef PROBE_MASK
#define PROBE_MASK 0
#endif
#define DBG_POOLY 0
#define DBG_BRSEL 1
#ifndef DBG_TWICE
#define DBG_TWICE 0
#endif
#ifndef GEMM_SIMPLE
#define GEMM_SIMPLE 0
#endif
#ifndef DBG_SAFE
#define DBG_SAFE 0
#endif
#ifndef DBG_PH_HI
#define DBG_PH_HI 20
#endif
#ifndef MK_PER_PHASE
#define MK_PER_PHASE 0
#endif

#define GAS __attribute__((address_space(1)))
#define LAS __attribute__((address_space(3)))
#define DI __device__ __forceinline__
typedef unsigned short bf16;
typedef unsigned v4u __attribute__((ext_vector_type(4)));
typedef unsigned v2u __attribute__((ext_vector_type(2)));
typedef float f32x4 __attribute__((ext_vector_type(4)));
typedef float f32x2 __attribute__((ext_vector_type(2)));
typedef short bf16x8 __attribute__((ext_vector_type(8)));

constexpr int D = 2048, NB = 8, SEQ = 4096, CTX = 256, DEPTH = 2;
constexpr int TL = NB * SEQ, TC = NB * CTX, MT = TL + TC;
constexpr int BRW = 512, INC = 3328, NGATE = 4 * D, N2 = INC + NGATE;
constexpr int NE = 16, DE = 1024, ECAP = MT;
constexpr int MAXTILES = 288;
constexpr float EPS = 1e-6f;
constexpr int U_RX = 0, U_K = 512, U_V = 640, U_AU = 768, U_AG = 1280, U_RG = 1792, U_Q = 2304, U_P = 2816;
constexpr int B_A = 0, B_B = 512, B_C = 1024, B_D = 1536;
constexpr int MO_SH1 = 0, MO_SC1 = 2048, MO_G1 = 4096, MO_SH2 = 6144, MO_SC2 = 8192, MO_G2 = 10240, MODW = 12288;

constexpr size_t MiB = 1u << 20;
constexpr size_t WS_CTL = 0, CTL_BYTES = 1 * MiB;
constexpr size_t WS_MOD = 1 * MiB;
constexpr size_t WS_LIST = 2 * MiB;
constexpr size_t LIST_ROW = 0, LIST_W = (size_t)NE * ECAP * 4, LIST_TS = 2 * (size_t)NE * ECAP * 4, LIST_CT = LIST_TS + (size_t)MT * 2 * 4;
constexpr size_t WS_SMALLW = 7 * MiB;
constexpr size_t SW_LRU = 0, SW_POOL = 262144;
constexpr size_t WS_W2 = 8 * MiB;
constexpr size_t WS_WB = 53 * MiB;
constexpr size_t WS_WO = 61 * MiB;
constexpr size_t WS_WGU = 69 * MiB;
constexpr size_t WS_WD = 197 * MiB;
constexpr size_t WS_H = 261 * MiB;
constexpr size_t WS_U = 397 * MiB;
constexpr size_t WS_G = 618 * MiB;
constexpr size_t WS_HB = WS_G, WS_O = WS_G + 144 * MiB;
constexpr size_t WS_BR = 1050 * MiB;
constexpr size_t WS_XB = 1186 * MiB;
constexpr size_t WS_H8 = 1322 * MiB;
constexpr size_t WS_END = 1390 * MiB;
constexpr size_t W2G_OFF = (size_t)INC * D * 2;
constexpr int CW_TMO = 0;
constexpr int CW_BAR = 4096;
constexpr int CW_CNT = 16384;
constexpr int CW_QUEUE = 20480;

constexpr int RING_BYTES = 131072;
constexpr int LDSCTL_OFF = RING_BYTES;
constexpr int LDS_BYTES = 163840;
constexpr int LDS_MODV = 147456;

DI float bf2f(unsigned b) { return __uint_as_float(b << 16); }
DI float bflo(unsigned w) { return __uint_as_float(w << 16); }
DI float bfhi(unsigned w) { return __uint_as_float(w & 0xffff0000u); }
DI unsigned f2bf(float f) { unsigned u = __float_as_uint(f); return (u + 0x7fffu + ((u >> 16) & 1u)) >> 16; }
DI unsigned pk2(float lo, float hi) { return f2bf(lo) | (f2bf(hi) << 16); }
typedef __bf16 bf16x2_t __attribute__((ext_vector_type(2)));
DI unsigned cvt_pk_bf16(float lo, float hi) { const f32x2 v = {lo, hi}; const bf16x2_t b = __builtin_convertvector(v, bf16x2_t); return __builtin_bit_cast(unsigned, b); }
DI int lane_id_asm() { int l; asm volatile("v_mbcnt_lo_u32_b32 %0, -1, 0\n\tv_mbcnt_hi_u32_b32 %0, -1, %0" : "=v"(l)); return l; }
template <int M> DI float sx(float v) {
    if constexpr (M < 32) return __builtin_bit_cast(float, __builtin_amdgcn_ds_swizzle(__builtin_bit_cast(int, v), 0x1f | (M << 10)));
    else { const int idx = (lane_id_asm() ^ 32) << 2; return __builtin_bit_cast(float, __builtin_amdgcn_ds_bpermute(idx, __builtin_bit_cast(int, v))); }
}
typedef int v8i __attribute__((ext_vector_type(8)));
typedef int v4i __attribute__((ext_vector_type(4)));
DI float clamp448(float v) { return __builtin_amdgcn_fmed3f(v, -448.0f, 448.0f); }
DI unsigned fp8x4(float a, float b, float c, float d) { int r = __float_as_int(a);
    r = __builtin_amdgcn_cvt_pk_fp8_f32(clamp448(a), clamp448(b), r, false); r = __builtin_amdgcn_cvt_pk_fp8_f32(clamp448(c), clamp448(d), r, true); return (unsigned)r; }
constexpr float S_ACT = 16.0f, S_W = 512.0f, S_HB = 8.0f;
constexpr float SC_GU = 1.0f / (S_ACT * S_W), SC_DN = 1.0f / (S_HB * S_W);
DI float wave_sum(float v) { v += sx<1>(v); v += sx<2>(v); v += sx<4>(v); v += sx<8>(v); v += sx<16>(v); v += sx<32>(v); return v; }
DI float wave_max(float v) { v = fmaxf(v, sx<1>(v)); v = fmaxf(v, sx<2>(v)); v = fmaxf(v, sx<4>(v)); v = fmaxf(v, sx<8>(v)); v = fmaxf(v, sx<16>(v)); v = fmaxf(v, sx<32>(v)); return v; }
DI float sigmoidf_(float x) { return 1.0f / (1.0f + __expf(-x)); }
DI float siluf_(float x) { return x / (1.0f + __expf(-x)); }
DI float gelu_tanh(float x) { const float u = 0.7978845608028654f * (x + 0.044715f * x * x * x); const float e = __expf(2.0f * u); const float t = 1.0f - 2.0f * __builtin_amdgcn_rcpf(e + 1.0f); return 0.5f * x * (1.0f + t); }
#define LDS_WAIT() asm volatile("s_waitcnt lgkmcnt(0)" ::: "memory")
#define VM_WAIT() asm volatile("s_waitcnt vmcnt(0)" ::: "memory")
#define LBAR() do { asm volatile("s_waitcnt lgkmcnt(0)" ::: "memory"); __builtin_amdgcn_s_barrier(); asm volatile("" ::: "memory"); } while (0)

#define XB_TMO      128
#define XB_XCNT(j)  (256  + 64 * (j))
#define XB_XSUB(j)  (1280 + 64 * (j))
#define XB_XGEN(j)  (2304 + 64 * (j))
#define XB_TOP      3328
#define XB_TOPGEN   3392
#define XCD_BAR_WORDS 3456
#define XB_SPIN_CAP (1u << 20)
DI unsigned xb_ld(unsigned* p)              { return __hip_atomic_load(p, __ATOMIC_RELAXED, __HIP_MEMORY_SCOPE_AGENT); }
DI unsigned xb_add(unsigned* p, unsigned v) { return __hip_atomic_fetch_add(p, v, __ATOMIC_RELAXED, __HIP_MEMORY_SCOPE_AGENT); }
DI unsigned xb_xcc_id() { return (unsigned)__builtin_amdgcn_s_getreg((3 << 11) | 20) & 0xFu; }
#define XB_SPIN(cond, bar) do { unsigned _sp = 0; while (cond) { __builtin_amdgcn_s_sleep(1); \
    if ((++_sp & 255u) == 0u) { if (xb_ld(&(bar)[XB_TMO])) break; if (_sp > XB_SPIN_CAP) { atomicAdd(&(bar)[XB_TMO], 1u); break; } } } } while (0)
struct XcdBarrier { unsigned* bar; unsigned x; volatile LAS unsigned* st; };
DI XcdBarrier xcd_barrier_post(unsigned* bar, volatile LAS unsigned* st) {
    XcdBarrier b; b.bar = bar; b.x = xb_xcc_id(); b.st = st;
    if (threadIdx.x == 0) (void)xb_add(&bar[XB_XCNT(b.x)], 1u);
    return b;
}
DI void xcd_barrier_complete(unsigned* bar, unsigned x, unsigned& nloc, unsigned& nx) {
    const unsigned G = gridDim.x * gridDim.y * gridDim.z;
    unsigned sum, cnt, mine, sp = 0u;
    for (;;) {
        sum = 0u; cnt = 0u; mine = 0u;
#pragma unroll
        for (unsigned j = 0; j < 16; ++j) { const unsigned c = xb_ld(&bar[XB_XCNT(j)]); sum += c; cnt += (c > 0u) ? 1u : 0u; mine = (j == x) ? c : mine; }
        if (sum == G) break;
        __builtin_amdgcn_s_sleep(1);
        if ((++sp & 255u) == 0u) { if (xb_ld(&bar[XB_TMO])) break; if (sp > XB_SPIN_CAP) { atomicAdd(&bar[XB_TMO], 1u); break; } }
    }
    nloc = mine > 0u ? mine : 1u; nx = cnt > 0u ? cnt : 1u;
}
DI void xcd_barrier(const XcdBarrier& b) {
    asm volatile("s_waitcnt vmcnt(0)" ::: "memory");
    __syncthreads();
    if (threadIdx.x == 0) {
        unsigned* bar = b.bar;
        __builtin_amdgcn_s_waitcnt(0);
        unsigned nloc = b.st[0], nx = b.st[1];
        if (nloc == 0u) { xcd_barrier_complete(bar, b.x, nloc, nx); b.st[0] = nloc; b.st[1] = nx; }
        const unsigned old = xb_add(&bar[XB_XSUB(b.x)], 1u);
        const unsigned gen = old / nloc;
        if (old + 1u == (gen + 1u) * nloc) {
            __builtin_amdgcn_fence(__ATOMIC_RELEASE, "agent");
            asm volatile("s_waitcnt vmcnt(0)" ::: "memory");
            const unsigned og = xb_add(&bar[XB_TOP], 1u);
            const unsigned tg = og / nx;
            if (og + 1u == (tg + 1u) * nx) xb_add(&bar[XB_TOPGEN], 1u);
            else XB_SPIN(xb_ld(&bar[XB_TOPGEN]) == tg, bar);
            __builtin_amdgcn_fence(__ATOMIC_ACQUIRE, "agent");
            xb_add(&bar[XB_XGEN(b.x)], 1u);
            asm volatile("s_waitcnt vmcnt(0)" ::: "memory");
        } else {
            XB_SPIN(xb_ld(&bar[XB_XGEN(b.x)]) == gen, bar);
            __builtin_amdgcn_fence(__ATOMIC_ACQUIRE, "agent");
            asm volatile("s_waitcnt vmcnt(0)" ::: "memory");
        }
    }
    __syncthreads();
}

namespace pg8 {
constexpr int BM = 256, BK = 64, HALF = 128, HTB = HALF * BK * 2, STAGE_BYTES = 8 * HTB, NXCD = 8, WGM = 8;
__host__ __device__ __forceinline__ int lds_byte(int r, int c) { const int st = (r >> 4) * 2 + (c >> 5), rr = r & 15, cc = c & 31, ob = rr * 64 + cc * 2; return st * 1024 + (ob ^ (((ob >> 9) & 1) << 5)); }
__host__ __device__ __forceinline__ void stage_rc(int b, int& R, int& C) { const int st = b / 1024, sb = b % 1024, swz = sb ^ (((sb >> 9) & 1) << 5); R = (st >> 1) * 16 + swz / 64; C = (st & 1) * 32 + (swz % 64) / 2; }
__host__ __device__ __forceinline__ int perm32(int rho) { const int n = rho >> 4, i = rho & 15; return 8 * (i >> 2) + 4 * n + (i & 3); }

struct Unit {
    const char* a;
    const char* b;
    const int* rows;
    int nvalid;
    int i0, i1, i2, i3;
};
DI void tile_of(int L, int nM, int nN, int& pm, int& pn) {
    const int nwg = nM * nN; int wgid = L;
    { const int q = nwg / NXCD, r = nwg % NXCD, xcd = wgid % NXCD, off = wgid / NXCD; wgid = (xcd < r ? xcd * (q + 1) : r * (q + 1) + (xcd - r) * q) + off; }
    const int nig = WGM * nN, gid = wgid / nig, fm = gid * WGM, gsz = (nM - fm) < WGM ? (nM - fm) : WGM;
    pm = fm + ((wgid % nig) % gsz); pn = (wgid % nig) / gsz;
}

template <class Epi, class Sched, bool GATHER, bool F8 = false>
DI void gemm_phase(LAS unsigned char* lds, const int wid, const int K, const unsigned lda, const unsigned ldb, const Sched& S, const Epi& E) {
    const int lane = lane_id_asm(), tid = wid * 64 + lane; const int wr = wid >> 2, wc = wid & 3, fr = lane & 15, fq = lane >> 4;
    const int nt = K / BK;
    unsigned voffA[2], voffB[2]; int RA[2], CA2[2];
#pragma unroll
    for (int i = 0; i < 2; ++i) { int R, C; stage_rc(tid * 16 + i * 8192, R, C); const int Rb = Epi::PERM ? ((R & ~31) + perm32(R & 31)) : R;
        RA[i] = R; CA2[i] = C * 2; voffA[i] = (unsigned)R * lda + (unsigned)C * 2u; voffB[i] = (unsigned)Rb * ldb + (unsigned)C * 2u; }
    const size_t kstep = (size_t)(BK * 2);
    const size_t hstepA = GATHER ? 0 : (size_t)HALF * lda, hstepB = (size_t)HALF * ldb;
    const unsigned ldsw = (unsigned)wid * 1024u;
    const int aoff = lds_byte(wr * 64 + fr, fq * 8), boff = lds_byte(wc * 32 + fr, fq * 8);
#define PG8_SA(b, h) (((b) * 2 + (h)) * HTB)
#define PG8_SB(b, h) ((4 + (b) * 2 + (h)) * HTB)
#define PG8_GL(bufoff, gptr, o0, o1, ko) do { \
        __builtin_amdgcn_global_load_lds((const unsigned*)((const char*)(gptr) + (unsigned)((o0) + (ko))), (LAS unsigned*)(lds + (bufoff) + ldsw), 16, 0, 0); \
        __builtin_amdgcn_global_load_lds((const unsigned*)((const char*)(gptr) + (unsigned)((o1) + (ko))), (LAS unsigned*)(lds + (bufoff) + ldsw + 8192), 16, 0, 0); } while (0)
#define PG8_STB(bufoff, gptr, ko) PG8_GL(bufoff, gptr, voffB[0], voffB[1], ko)
#define PG8_STA(bufoff, gptr, h, nx, ko) do { if constexpr (GATHER) { const unsigned _o0 = (nx) ? gn[h][0] : gc[h][0], _o1 = (nx) ? gn[h][1] : gc[h][1]; PG8_GL(bufoff, gptr, _o0, _o1, ko); } \
        else { PG8_GL(bufoff, (gptr) + (h) * hstepA, voffA[0], voffA[1], ko); } } while (0)
#define PG8_CAT(p) __builtin_shufflevector(*(const LAS v4i*)(p), *(const LAS v4i*)((p) + 1024), 0, 1, 2, 3, 4, 5, 6, 7)
#define PG8_LDA(dst, b, h) do { _Pragma("unroll") for (int m = 0; m < 4; ++m) dst[m] = PG8_CAT(lds + PG8_SA(b, h) + aoff + m * 2048); } while (0)
#define PG8_LDB(dst, b, h) do { _Pragma("unroll") for (int n = 0; n < 2; ++n) dst[n] = PG8_CAT(lds + PG8_SB(b, h) + boff + n * 2048); } while (0)
#define PG8_LO(x) __builtin_bit_cast(bf16x8, __builtin_shufflevector(x, x, 0, 1, 2, 3))
#define PG8_HI(x) __builtin_bit_cast(bf16x8, __builtin_shufflevector(x, x, 4, 5, 6, 7))
#define PG8_MMA(ai, bj, At, Bt) do { __builtin_amdgcn_s_setprio(1); _Pragma("unroll") for (int m = 0; m < 4; ++m) _Pragma("unroll") for (int n = 0; n < 2; ++n) { \
        if constexpr (F8) acc[ai][bj][m][n] = __builtin_amdgcn_mfma_scale_f32_16x16x128_f8f6f4(Bt[n], At[m], acc[ai][bj][m][n], 0, 0, 0, 0, 0, 0); \
        else { acc[ai][bj][m][n] = __builtin_amdgcn_mfma_f32_16x16x32_bf16(PG8_LO(Bt[n]), PG8_LO(At[m]), acc[ai][bj][m][n], 0, 0, 0); \
               acc[ai][bj][m][n] = __builtin_amdgcn_mfma_f32_16x16x32_bf16(PG8_HI(Bt[n]), PG8_HI(At[m]), acc[ai][bj][m][n], 0, 0, 0); } } \
        __builtin_amdgcn_s_setprio(0); } while (0)
#if DBG_SAFE
#define PG8_WAIT_V(n) asm volatile("s_waitcnt vmcnt(0)" ::: "memory")
#else
#define PG8_WAIT_V(n) asm volatile("s_waitcnt vmcnt(" #n ")" ::: "memory")
#endif
#define PG8_WAIT_L(n) asm volatile("s_waitcnt lgkmcnt(" #n ")" ::: "memory")
#define PG8_BAR __builtin_amdgcn_s_barrier()
#define PG8_SCHED __builtin_amdgcn_sched_barrier(0)
    Unit cur, nxt; int ui = 0;
    if (!S.next(0, cur)) return;
    unsigned gc[2][2], gn[2][2];
    if constexpr (GATHER) {
#pragma unroll
        for (int h = 0; h < 2; ++h)
#pragma unroll
            for (int i = 0; i < 2; ++i) { const int rr = h * HALF + RA[i]; const int idx = rr < cur.nvalid ? *(const int*)((const char*)cur.rows + (unsigned)rr * 4u) : 0; gc[h][i] = (unsigned)idx * lda + (unsigned)CA2[i]; gn[h][i] = gc[h][i]; }
    }
    f32x4 acc[2][2][4][2];
#pragma unroll
    for (int a = 0; a < 2; ++a)
#pragma unroll
        for (int b = 0; b < 2; ++b)
#pragma unroll
            for (int m = 0; m < 4; ++m)
#pragma unroll
                for (int n = 0; n < 2; ++n) acc[a][b][m][n] = (f32x4){0.f, 0.f, 0.f, 0.f};
    const char* cA = cur.a; const char* cB = cur.b;
    PG8_STB(PG8_SB(0, 0), cB, 0u); PG8_STB(PG8_SB(0, 1), cB + hstepB, 0u); PG8_STA(PG8_SA(0, 0), cA, 0, false, 0u); PG8_STA(PG8_SA(0, 1), cA, 1, false, 0u);
    if (wr == 1) PG8_BAR;
    PG8_WAIT_V(2); PG8_BAR;
    PG8_STB(PG8_SB(1, 0), cB, 128u); PG8_STA(PG8_SA(1, 0), cA, 0, false, 128u); PG8_STB(PG8_SB(1, 1), cB + hstepB, 128u);
    PG8_WAIT_V(6); PG8_BAR;
    for (;;) {
        const bool has_next = S.next(ui + 1, nxt);
        const char* nA = has_next ? nxt.a : cA; const char* nB = has_next ? nxt.b : cB;
        if constexpr (GATHER) {
            if (has_next) {
                const int tid2 = wid * 64 + lane_id_asm();
#pragma unroll
                for (int i = 0; i < 2; ++i) { int R, C; stage_rc(tid2 * 16 + i * 8192, R, C);
#pragma unroll
                    for (int h = 0; h < 2; ++h) { const int rr = h * HALF + R; const int idx = rr < nxt.nvalid ? *(const int*)((const char*)nxt.rows + (unsigned)rr * 4u) : 0; gn[h][i] = (unsigned)idx * lda + (unsigned)C * 2u; } }
            } else {
#pragma unroll
                for (int h = 0; h < 2; ++h)
#pragma unroll
                    for (int i = 0; i < 2; ++i) gn[h][i] = gc[h][i];
            }
        }
#pragma unroll 1
        for (int t = 0; t < nt; t += 2) {
            const bool last = (t == nt - 2);
            v8i At[4], B0[2], B1[2];
            const unsigned k1 = (unsigned)(t + 1) * 128u, k2 = last ? 0u : (unsigned)(t + 2) * 128u, k3 = k2 + 128u;
            const char* a2 = last ? nA : cA; const char* b2 = last ? nB : cB;
            PG8_LDB(B0, 0, 0); PG8_LDB(B1, 0, 1); PG8_SCHED; PG8_LDA(At, 0, 0); PG8_STA(PG8_SA(1, 1), cA, 1, false, k1);
            PG8_WAIT_V(8); PG8_WAIT_L(0); PG8_BAR; PG8_MMA(0, 0, At, B0); PG8_MMA(0, 1, At, B1); PG8_BAR; PG8_SCHED;
            PG8_LDA(At, 0, 1); PG8_STB(PG8_SB(0, 0), b2, k2); PG8_STB(PG8_SB(0, 1), b2 + hstepB, k2); PG8_STA(PG8_SA(0, 0), a2, 0, last, k2);
            PG8_WAIT_V(8); PG8_WAIT_L(0); PG8_BAR; PG8_MMA(1, 0, At, B0); PG8_MMA(1, 1, At, B1); PG8_BAR; PG8_SCHED;
            PG8_LDB(B0, 1, 0); PG8_LDB(B1, 1, 1); PG8_SCHED; PG8_LDA(At, 1, 0); PG8_STA(PG8_SA(0, 1), a2, 1, last, k2);
            PG8_WAIT_V(8); PG8_WAIT_L(0); PG8_BAR; PG8_MMA(0, 0, At, B0); PG8_MMA(0, 1, At, B1); PG8_BAR; PG8_SCHED;
            PG8_LDA(At, 1, 1); PG8_STB(PG8_SB(1, 0), b2, k3); PG8_STB(PG8_SB(1, 1), b2 + hstepB, k3); PG8_STA(PG8_SA(1, 0), a2, 0, last, k3);
            PG8_WAIT_V(8); PG8_WAIT_L(0); PG8_BAR; PG8_MMA(1, 0, At, B0); PG8_MMA(1, 1, At, B1); PG8_BAR; PG8_SCHED;
        }
        if (wr == 0) PG8_BAR;
        const int ln_ = lane_id_asm(), fr_ = ln_ & 15, fq_ = ln_ >> 4;
        const bool keep = E(acc, cur, wr, wc, fr_, fq_);
        if (!has_next) break;
        if (!keep) {
#pragma unroll
            for (int a = 0; a < 2; ++a)
#pragma unroll
                for (int b = 0; b < 2; ++b)
#pragma unroll
                    for (int m = 0; m < 4; ++m)
#pragma unroll
                        for (int n = 0; n < 2; ++n) acc[a][b][m][n] = (f32x4){0.f, 0.f, 0.f, 0.f};
        }
        cur = nxt; cA = nA; cB = nB; ++ui;
        if constexpr (GATHER) {
#pragma unroll
            for (int h = 0; h < 2; ++h)
#pragma unroll
                for (int i = 0; i < 2; ++i) gc[h][i] = gn[h][i];
        }
        if (wr == 1) PG8_BAR;
    }
    PG8_WAIT_V(0);
    PG8_BAR;
#undef PG8_SA
#undef PG8_SB
#undef PG8_GL
#undef PG8_STB
#undef PG8_STA
#undef PG8_CAT
#undef PG8_LO
#undef PG8_HI
#undef PG8_LDA
#undef PG8_LDB
#undef PG8_MMA
#undef PG8_WAIT_V
#undef PG8_WAIT_L
#undef PG8_BAR
#undef PG8_SCHED
}

template <class Epi, class Sched, bool GATHER>
DI void gemm_phase_simple(LAS unsigned char* lds, const int wid, const int K, const unsigned lda, const unsigned ldb, const Sched& S, const Epi& E) {
    const int lane = lane_id_asm(), tid = wid * 64 + lane; const int wr = wid >> 2, wc = wid & 3, fr = lane & 15, fq = lane >> 4;
    const int nt = K / BK;
    unsigned voffA[2], voffB[2]; int RA[2], CA2[2];
#pragma unroll
    for (int i = 0; i < 2; ++i) { int R, C; stage_rc(tid * 16 + i * 8192, R, C); const int Rb = Epi::PERM ? ((R & ~31) + perm32(R & 31)) : R;
        RA[i] = R; CA2[i] = C * 2; voffA[i] = (unsigned)R * lda + (unsigned)C * 2u; voffB[i] = (unsigned)Rb * ldb + (unsigned)C * 2u; }
    const size_t hstepA = (size_t)HALF * lda, hstepB = (size_t)HALF * ldb;
    const int aoff = lds_byte(wr * 64 + fr, fq * 8), boff = lds_byte(wc * 32 + fr, fq * 8);
    Unit cur;
    f32x4 acc[2][2][4][2];
#pragma unroll
        for (int a = 0; a < 2; ++a)
#pragma unroll
            for (int b = 0; b < 2; ++b)
#pragma unroll
                for (int m = 0; m < 4; ++m)
#pragma unroll
                    for (int n = 0; n < 2; ++n) acc[a][b][m][n] = (f32x4){0.f, 0.f, 0.f, 0.f};
    for (int ui = 0; S.next(ui, cur); ++ui) {
        unsigned ga[2][2];
#pragma unroll
        for (int h = 0; h < 2; ++h)
#pragma unroll
            for (int i = 0; i < 2; ++i) {
                if constexpr (GATHER) { const int rr = h * HALF + RA[i]; const int idx = rr < cur.nvalid ? *(const int*)((const char*)cur.rows + (unsigned)rr * 4u) : 0; ga[h][i] = (unsigned)idx * lda + (unsigned)CA2[i]; }
                else ga[h][i] = (unsigned)(h * hstepA) + voffA[i];
            }
        for (int t = 0; t < nt; ++t) {
            v4u ra[2][2], rb[2][2];
#pragma unroll
            for (int h = 0; h < 2; ++h)
#pragma unroll
                for (int i = 0; i < 2; ++i) { ra[h][i] = *(const v4u*)(cur.a + (size_t)t * 128 + ga[h][i]); rb[h][i] = *(const v4u*)(cur.b + (size_t)t * 128 + h * hstepB + voffB[i]); }
            __syncthreads();
#pragma unroll
            for (int h = 0; h < 2; ++h)
#pragma unroll
                for (int i = 0; i < 2; ++i) { *(LAS v4u*)(lds + h * HTB + tid * 16 + i * 8192) = ra[h][i]; *(LAS v4u*)(lds + (4 + h) * HTB + tid * 16 + i * 8192) = rb[h][i]; }
            __syncthreads();
#pragma unroll
            for (int ai = 0; ai < 2; ++ai) {
                bf16x8 At[4][2];
#pragma unroll
                for (int m = 0; m < 4; ++m)
#pragma unroll
                    for (int k = 0; k < 2; ++k) At[m][k] = *(const LAS bf16x8*)(lds + ai * HTB + aoff + m * 2048 + k * 1024);
#pragma unroll
                for (int bj = 0; bj < 2; ++bj) {
                    bf16x8 Bt[2][2];
#pragma unroll
                    for (int n = 0; n < 2; ++n)
#pragma unroll
                        for (int k = 0; k < 2; ++k) Bt[n][k] = *(const LAS bf16x8*)(lds + (4 + bj) * HTB + boff + n * 2048 + k * 1024);
#pragma unroll
                    for (int m = 0; m < 4; ++m)
#pragma unroll
                        for (int n = 0; n < 2; ++n)
#pragma unroll
                            for (int k = 0; k < 2; ++k) acc[ai][bj][m][n] = __builtin_amdgcn_mfma_f32_16x16x32_bf16(Bt[n][k], At[m][k], acc[ai][bj][m][n], 0, 0, 0);
                }
            }
        }
        asm volatile("s_nop 15\n\ts_nop 15" ::: "memory");
        const bool keep = E(acc, cur, wr, wc, fr, fq);
        if (!keep) {
#pragma unroll
            for (int a = 0; a < 2; ++a)
#pragma unroll
                for (int b = 0; b < 2; ++b)
#pragma unroll
                    for (int m = 0; m < 4; ++m)
#pragma unroll
                        for (int n = 0; n < 2; ++n) acc[a][b][m][n] = (f32x4){0.f, 0.f, 0.f, 0.f};
        }
    }
    __syncthreads();
}
}
using pg8::Unit;
#if GEMM_SIMPLE
#define GEMM_PHASE gemm_phase_simple
#else
#define GEMM_PHASE gemm_phase
#endif

struct Params {
    const float* in[34];
    float* out; unsigned char* ws;
    int ph_lo, ph_hi;
};
enum { I_X = 0, I_C, I_CTX, I_CCTX, I_WADA, I_BADA, I_NMG, I_NFG, I_WIN, I_CONVW, I_CONVB, I_CLNG, I_CLNB, I_LCW, I_LCB, I_LWA, I_LBA, I_LWX, I_LBX, I_LLAM,
       I_QNG, I_KNG, I_SINK, I_POOLW, I_POOLS, I_WBR, I_WGATE, I_BGATE, I_WOUT, I_WROUTER, I_RBIAS, I_EWG, I_EWU, I_EWD };
struct Frame {
    LAS unsigned char* lds;
    unsigned* ctl;
    int tid, lane, wave, G, bid;
    const __attribute__((address_space(4))) Params* p;
    unsigned char* ws;
};
#define WSP(T, off) ((T*)(F.ws + (off)))

DI void mod_gemv(Frame& F) {
    if (F.bid >= 192) return;
    const int l = F.bid / 96, col0 = (F.bid % 96) * 128;
    LAS float* sc9 = (LAS float*)F.lds;
    LAS float* red = (LAS float*)(F.lds + 73728);
    const float* c = F.p->in[I_C]; const float* cc = F.p->in[I_CCTX];
    for (int i = F.tid; i < 9 * D; i += 512) { const int r = i / D, k = i % D; const float v = (r < 8) ? c[r * D + k] : cc[k]; sc9[i] = siluf_(v); }
    __syncthreads();
    float acc[9][2];
#pragma unroll
    for (int r = 0; r < 9; ++r) { acc[r][0] = 0.f; acc[r][1] = 0.f; }
    const int k0 = F.wave * 256;
    const float2* wp = (const float2*)(F.p->in[I_WADA] + (size_t)l * D * MODW + (size_t)k0 * MODW + col0 + 2 * F.lane);
#pragma unroll 8
    for (int kk = 0; kk < 256; ++kk) {
        const float2 wv = wp[(size_t)kk * (MODW / 2)];
#pragma unroll
        for (int r = 0; r < 9; ++r) { const float s = sc9[r * D + k0 + kk]; acc[r][0] += s * wv.x; acc[r][1] += s * wv.y; }
    }
#pragma unroll
    for (int r = 0; r < 9; ++r) { red[(F.wave * 9 + r) * 128 + 2 * F.lane] = acc[r][0]; red[(F.wave * 9 + r) * 128 + 2 * F.lane + 1] = acc[r][1]; }
    __syncthreads();
    float* mod = WSP(float, WS_MOD);
    const float* bada = F.p->in[I_BADA];
    for (int i = F.tid; i < 9 * 128; i += 512) { const int r = i / 128, n = i % 128; float s = 0.f;
#pragma unroll
        for (int w = 0; w < 8; ++w) s += red[(w * 9 + r) * 128 + n];
        mod[(size_t)(l * 9 + r) * MODW + col0 + n] = s + bada[l * MODW + col0 + n]; }
    __syncthreads();
}

DI void cvt_item(const float* W, int Nsrc, int k0, int n0, bf16* WT, size_t drow0, int Kd, LAS float* scr, int lane) {
#pragma unroll 8
    for (int i = 0; i < 32; ++i) { const int kk = 2 * i + (lane >> 5); scr[kk * 33 + (lane & 31)] = W[(size_t)(k0 + kk) * Nsrc + n0 + (lane & 31)]; }
    LDS_WAIT(); asm volatile("" ::: "memory");
    const int c = lane & 7;
#pragma unroll
    for (int j = 0; j < 4; ++j) { const int n = (lane >> 3) + 8 * j; const LAS float* s = scr + (8 * c) * 33 + n;
        v4u o; o.x = pk2(s[0 * 33], s[1 * 33]); o.y = pk2(s[2 * 33], s[3 * 33]); o.z = pk2(s[4 * 33], s[5 * 33]); o.w = pk2(s[6 * 33], s[7 * 33]);
        *(v4u*)(WT + (drow0 + n) * (size_t)Kd + k0 + 8 * c) = o; }
    LDS_WAIT(); asm volatile("" ::: "memory");
}
DI void cvt_item8(const float* W, int Nsrc, int k0, int n0, unsigned char* WT, size_t drow0, int Kd, float scale, LAS float* scr, int lane) {
#pragma unroll 8
    for (int i = 0; i < 32; ++i) { const int kk = 2 * i + (lane >> 5); scr[kk * 33 + (lane & 31)] = W[(size_t)(k0 + kk) * Nsrc + n0 + (lane & 31)]; }
    LDS_WAIT(); asm volatile("" ::: "memory");
    const int c = lane & 7;
#pragma unroll
    for (int j = 0; j < 4; ++j) { const int n = (lane >> 3) + 8 * j; const LAS float* s = scr + (8 * c) * 33 + n;
        v2u o; o.x = fp8x4(s[0 * 33] * scale, s[1 * 33] * scale, s[2 * 33] * scale, s[3 * 33] * scale); o.y = fp8x4(s[4 * 33] * scale, s[5 * 33] * scale, s[6 * 33] * scale, s[7 * 33] * scale);
        *(v2u*)(WT + (drow0 + n) * (size_t)Kd + k0 + 8 * c) = o; }
    LDS_WAIT(); asm volatile("" ::: "memory");
}
DI int win_dst(int n) {
    if (n < 512) return U_AU + n; if (n < 1024) return U_AG + (n - 512); if (n < 1536) return U_RX + (n - 1024); if (n < 2048) return U_RG + (n - 1536);
    if (n < 2560) return U_Q + (n - 2048); if (n < 2688) return U_K + (n - 2560); if (n < 2816) return U_V + (n - 2688); return U_P + (n - 2816);
}
DI void convert_weights(Frame& F, int l) {
    LAS float* scr = (LAS float*)(F.lds + F.wave * 16384);
    constexpr int I1 = 32 * 104, I2 = 4 * 32 * 64, I3 = 4 * 8 * 64, I4 = 32 * 64, I5 = 16 * 32 * 32, I6 = I5, I7 = 16 * 16 * 64, I8 = 16 * 2, I9 = 16 * 2, I10 = 4 * 2 * 4;
    constexpr int NIT = I1 + I2 + I3 + I4 + I5 + I6 + I7 + I8 + I9 + I10;
    bf16* W2 = WSP(bf16, WS_W2); bf16* WB = WSP(bf16, WS_WB); bf16* WO = WSP(bf16, WS_WO); bf16* WGU = WSP(bf16, WS_WGU); bf16* WD = WSP(bf16, WS_WD);
    bf16* WL = WSP(bf16, WS_SMALLW + SW_LRU); bf16* WP = WSP(bf16, WS_SMALLW + SW_POOL);
    const int gw = F.bid * 8 + F.wave, NGW = F.G * 8;
    for (int it = gw; it < NIT; it += NGW) {
        int r = it;
        if (r < I1) { const int kb = r / 104, nb = r % 104;
#if F8_WIN
            cvt_item8(F.p->in[I_WIN] + (size_t)l * D * INC, INC, kb * 64, nb * 32, (unsigned char*)W2, (size_t)win_dst(nb * 32), D, S_W, scr, F.lane);
#else
            cvt_item(F.p->in[I_WIN] + (size_t)l * D * INC, INC, kb * 64, nb * 32, W2, (size_t)win_dst(nb * 32), D, scr, F.lane);
#endif
            continue; } r -= I1;
        if (r < I2) { const int g = r / 2048, q = r % 2048, kb = q / 64, nb = q % 64; cvt_item8(F.p->in[I_WGATE] + ((size_t)l * 4 + g) * D * D, D, kb * 64, nb * 32, (unsigned char*)W2 + W2G_OFF, (size_t)g * D + nb * 32, D, S_W, scr, F.lane); continue; } r -= I2;
        if (r < I3) { const int g = r / 512, q = r % 512, kb = q / 64, nb = q % 64; cvt_item(F.p->in[I_WBR] + ((size_t)l * 4 + g) * BRW * D, D, kb * 64, nb * 32, WB, (size_t)g * D + nb * 32, BRW, scr, F.lane); continue; } r -= I3;
        if (r < I4) { const int kb = r / 64, nb = r % 64;
#if F8_WOUT
            cvt_item8(F.p->in[I_WOUT] + (size_t)l * D * D, D, kb * 64, nb * 32, (unsigned char*)WO, (size_t)nb * 32, D, S_W, scr, F.lane);
#else
            cvt_item(F.p->in[I_WOUT] + (size_t)l * D * D, D, kb * 64, nb * 32, WO, (size_t)nb * 32, D, scr, F.lane);
#endif
            continue; } r -= I4;
        if (r < I5) { const int e = r / 1024, q = r % 1024, kb = q / 32, nb = q % 32, n = nb * 32; cvt_item8(F.p->in[I_EWG] + ((size_t)l * NE + e) * D * DE, DE, kb * 64, n, (unsigned char*)WGU, (size_t)e * 2048 + (n / 128) * 256 + (n % 128), D, S_W, scr, F.lane); continue; } r -= I5;
        if (r < I6) { const int e = r / 1024, q = r % 1024, kb = q / 32, nb = q % 32, n = nb * 32; cvt_item8(F.p->in[I_EWU] + ((size_t)l * NE + e) * D * DE, DE, kb * 64, n, (unsigned char*)WGU, (size_t)e * 2048 + (n / 128) * 256 + 128 + (n % 128), D, S_W, scr, F.lane); continue; } r -= I6;
        if (r < I7) { const int e = r / 1024, q = r % 1024, kb = q / 64, nb = q % 64; cvt_item8(F.p->in[I_EWD] + ((size_t)l * NE + e) * DE * D, D, kb * 64, nb * 32, (unsigned char*)WD, (size_t)e * 2048 + nb * 32, DE, S_W, scr, F.lane); continue; } r -= I7;
        if (r < I8) { const int mat = r / 2, nb = r % 2;
            const int d = mat / 8, h = mat % 8; cvt_item(F.p->in[I_LWA] + (((size_t)l * 2 + d) * 8 + h) * 4096, 64, 0, nb * 32, WL, (size_t)((d * 2 + 0) * 8 + h) * 64 + nb * 32, 64, scr, F.lane); continue; } r -= I8;
        if (r < I9) { const int mat = r / 2, nb = r % 2;
            const int d = mat / 8, h = mat % 8; cvt_item(F.p->in[I_LWX] + (((size_t)l * 2 + d) * 8 + h) * 4096, 64, 0, nb * 32, WL, (size_t)((d * 2 + 1) * 8 + h) * 64 + nb * 32, 64, scr, F.lane); continue; } r -= I9;
        { const int g = r / 8, q = r % 8, kb = q / 4, nb = q % 4; cvt_item(F.p->in[I_POOLW] + ((size_t)l * 4 + g) * 16384, 128, kb * 64, nb * 32, WP, (size_t)g * 128 + nb * 32, 128, scr, F.lane); }
    }
}

constexpr int LC_SCR = LDSCTL_OFF + 256;

DI void norm_phase(Frame& F, int l, int mode) {
    const int gw = F.bid * 8 + F.wave, NGW = F.G * 8;
    LAS int* offs = (LAS int*)(F.lds + LC_SCR);
    const int lp = (mode == 1) ? l - 1 : DEPTH - 1;
    if (mode != 0) {
        if (F.tid == 0) { int acc = 0; for (int e = 0; e < NE; ++e) { const int c = (int)__hip_atomic_load(F.ctl + CW_CNT + (lp * 16 + e) * 64, __ATOMIC_RELAXED, __HIP_MEMORY_SCOPE_AGENT); offs[e] = acc * 256; acc += (c + 255) >> 8; } }
        __syncthreads();
    }
    const int nrows = (mode == 2) ? TL : MT;
    const float* mod = WSP(float, WS_MOD);
    const int* tokslot = (const int*)(F.ws + WS_LIST + LIST_TS);
    const bf16* O = WSP(bf16, WS_O);
    bf16* H = WSP(bf16, WS_H); unsigned char* H8 = WSP(unsigned char, WS_H8);
    int ns0 = 0, ns1 = 0;
    if (mode != 0 && gw < nrows) { ns0 = tokslot[gw * 2]; ns1 = tokslot[gw * 2 + 1]; }
#define NP_I4(j) (2 * (F.lane + 64 * ((j) >> 1)) + ((j) & 1))
#define NP_E8(jj) (8 * (F.lane + 64 * (jj)))
    for (int row = gw; row < nrows; row += NGW) {
        const bool lat = row < TL; const int bidx = lat ? row / SEQ : 8;
        bf16* xb = WSP(bf16, WS_XB) + (size_t)row * D;
        f32x4 v[8];
        if (mode == 0) { const float* xs = lat ? F.p->in[I_X] + (size_t)row * D : F.p->in[I_CTX] + (size_t)(row - TL) * D;
#pragma unroll
            for (int j = 0; j < 8; ++j) v[j] = ((const f32x4*)xs)[NP_I4(j)];
        } else {
#pragma unroll
            for (int jj = 0; jj < 4; ++jj) { const v4u t = *(const v4u*)(xb + NP_E8(jj));
                v[2 * jj] = (f32x4){bflo(t.x), bfhi(t.x), bflo(t.y), bfhi(t.y)}; v[2 * jj + 1] = (f32x4){bflo(t.z), bfhi(t.z), bflo(t.w), bfhi(t.w)}; }
        }
        if (mode != 0) {
            const int s0 = ns0, s1 = ns1;
            if (row + NGW < nrows) { ns0 = tokslot[(row + NGW) * 2]; ns1 = tokslot[(row + NGW) * 2 + 1]; }
            const size_t sl0 = (size_t)(offs[s0 >> 20] + (s0 & 0xfffff)), sl1 = (size_t)(offs[s1 >> 20] + (s1 & 0xfffff));
            const float* g2 = mod + (size_t)(lp * 9 + bidx) * MODW + MO_G2;
            v4u o0[4], o1[4]; f32x4 gv[8];
#pragma unroll
            for (int jj = 0; jj < 4; ++jj) { o0[jj] = *(const v4u*)(O + sl0 * D + NP_E8(jj)); o1[jj] = *(const v4u*)(O + sl1 * D + NP_E8(jj)); }
#pragma unroll
            for (int j = 0; j < 8; ++j) gv[j] = ((const f32x4*)g2)[NP_I4(j)];
#pragma unroll
            for (int jj = 0; jj < 4; ++jj) {
                v[2 * jj].x += gv[2 * jj].x * (bflo(o0[jj].x) + bflo(o1[jj].x)); v[2 * jj].y += gv[2 * jj].y * (bfhi(o0[jj].x) + bfhi(o1[jj].x));
                v[2 * jj].z += gv[2 * jj].z * (bflo(o0[jj].y) + bflo(o1[jj].y)); v[2 * jj].w += gv[2 * jj].w * (bfhi(o0[jj].y) + bfhi(o1[jj].y));
                v[2 * jj + 1].x += gv[2 * jj + 1].x * (bflo(o0[jj].z) + bflo(o1[jj].z)); v[2 * jj + 1].y += gv[2 * jj + 1].y * (bfhi(o0[jj].z) + bfhi(o1[jj].z));
                v[2 * jj + 1].z += gv[2 * jj + 1].z * (bflo(o0[jj].w) + bflo(o1[jj].w)); v[2 * jj + 1].w += gv[2 * jj + 1].w * (bfhi(o0[jj].w) + bfhi(o1[jj].w)); }
            if (mode == 2) { float* xd = F.p->out + (size_t)row * D;
#pragma unroll
                for (int j = 0; j < 8; ++j) ((f32x4*)xd)[NP_I4(j)] = v[j];
            } else {
#pragma unroll
                for (int jj = 0; jj < 4; ++jj) { v4u t; t.x = cvt_pk_bf16(v[2 * jj].x, v[2 * jj].y); t.y = cvt_pk_bf16(v[2 * jj].z, v[2 * jj].w); t.z = cvt_pk_bf16(v[2 * jj + 1].x, v[2 * jj + 1].y); t.w = cvt_pk_bf16(v[2 * jj + 1].z, v[2 * jj + 1].w);
                    *(v4u*)(xb + NP_E8(jj)) = t; }
            }
        }
        if (mode != 2) {
            float ss = 0.f;
#pragma unroll
            for (int j = 0; j < 8; ++j) ss += (v[j].x * v[j].x + v[j].y * v[j].y) + (v[j].z * v[j].z + v[j].w * v[j].w);
            ss = wave_sum(ss);
            const float r = 1.0f / sqrtf(ss * (1.0f / D) + EPS);
            const float* gain = F.p->in[I_NMG] + l * D; const float* sh = mod + (size_t)(l * 9 + bidx) * MODW + MO_SH1; const float* sc = mod + (size_t)(l * 9 + bidx) * MODW + MO_SC1;
            f32x4 gn[8], s_[8], b_[8];
#pragma unroll
            for (int j = 0; j < 8; ++j) { gn[j] = ((const f32x4*)gain)[NP_I4(j)]; s_[j] = ((const f32x4*)sc)[NP_I4(j)]; b_[j] = ((const f32x4*)sh)[NP_I4(j)]; }
#pragma unroll
            for (int jj = 0; jj < 4; ++jj) {
                float hq[8];
#pragma unroll
                for (int e = 0; e < 2; ++e) { const int j = 2 * jj + e;
                    hq[4 * e + 0] = (v[j].x * r) * gn[j].x * (1.0f + s_[j].x) + b_[j].x; hq[4 * e + 1] = (v[j].y * r) * gn[j].y * (1.0f + s_[j].y) + b_[j].y;
                    hq[4 * e + 2] = (v[j].z * r) * gn[j].z * (1.0f + s_[j].z) + b_[j].z; hq[4 * e + 3] = (v[j].w * r) * gn[j].w * (1.0f + s_[j].w) + b_[j].w; }
                v4u o; o.x = pk2(hq[0], hq[1]); o.y = pk2(hq[2], hq[3]); o.z = pk2(hq[4], hq[5]); o.w = pk2(hq[6], hq[7]);
                if (!F8_WIN) *(v4u*)(H + (size_t)row * D + NP_E8(jj)) = o;
                v2u o8; o8.x = fp8x4(hq[0] * S_ACT, hq[1] * S_ACT, hq[2] * S_ACT, hq[3] * S_ACT); o8.y = fp8x4(hq[4] * S_ACT, hq[5] * S_ACT, hq[6] * S_ACT, hq[7] * S_ACT);
                *(v2u*)(H8 + (size_t)row * D + NP_E8(jj)) = o8;
            }
        }
    }
#undef NP_I4
#undef NP_E8
}

#if PROBE_RT
#define RP_T0() unsigned long long rp_t_ = __builtin_amdgcn_s_memrealtime()
#define RP_END(bit) do { const unsigned long long t1_ = __builtin_amdgcn_s_memrealtime(); if (PROBE_RT & (bit)) { const unsigned long long dt_ = t1_ - rp_t_; while (__builtin_amdgcn_s_memrealtime() - t1_ < dt_) __builtin_amdgcn_s_sleep(4); } rp_t_ = __builtin_amdgcn_s_memrealtime(); } while (0)
#else
#define RP_T0() do { } while (0)
#define RP_END(bit) do { } while (0)
#endif
DI void router_phase(Frame& F, int l) {
    const int nrows = (l == 0) ? MT : TL, rpw = nrows / F.G;
    auto row_of = [&](int lr) { return (lr < 128) ? F.bid * 128 + lr : TL + F.bid * 8 + (lr - 128); };
    LAS unsigned char* frag = F.lds;
    LAS int* asg_e = (LAS int*)(F.lds + LC_SCR);
    LAS float* asg_w = (LAS float*)(F.lds + LC_SCR + 1088);
    LAS int* asg_r = (LAS int*)(F.lds + LC_SCR + 2176);
    LAS float* part = (LAS float*)(F.lds + LC_SCR + 4096);
    for (int s2 = F.tid; s2 < 272; s2 += 512) asg_e[s2] = -1;
    const float* wrt = F.p->in[I_WROUTER];
    float wb[64];
#pragma unroll
    for (int q = 0; q < 64; ++q) wb[q] = wrt[(size_t)(4 * (64 * F.wave + q) + (F.lane >> 4)) * NE + (F.lane & 15)];
    const float* mod = WSP(float, WS_MOD);
    unsigned char* H2 = WSP(unsigned char, WS_H);
    const float* gain = F.p->in[I_NFG] + l * D;
    LAS float* lm = (LAS float*)(F.lds + LDS_MODV);
    const bf16* XBp = WSP(bf16, WS_XB);
    int staged = -1;
    v2u xq[2][8];
#pragma unroll
    for (int t2 = 0; t2 < 2; ++t2) { const int lr = 2 * F.wave + t2; const int row = row_of((lr < rpw) ? lr : 0);
#pragma unroll
        for (int j = 0; j < 8; ++j) xq[t2][j] = *(const v2u*)(XBp + (size_t)row * D + 4 * F.lane + 256 * j); }
    __syncthreads();
    RP_T0();
    for (int g0 = 0; g0 < rpw; g0 += 16) {
        { const int rowg = row_of(g0), bg = (rowg < TL) ? rowg / SEQ : 8;
          if (bg != staged) {
              const float* sh = mod + (size_t)(l * 9 + bg) * MODW + MO_SH2; const float* sc = mod + (size_t)(l * 9 + bg) * MODW + MO_SC2;
              { const f32x4 g_ = ((const f32x4*)gain)[F.tid], c_ = ((const f32x4*)sc)[F.tid], h_ = ((const f32x4*)sh)[F.tid];
                ((LAS f32x4*)lm)[F.tid] = g_ * (1.0f + c_); ((LAS f32x4*)(lm + 2048))[F.tid] = h_; }
              staged = bg;
              __syncthreads();
          } }
        v2u xc[2][8];
#pragma unroll
        for (int t2 = 0; t2 < 2; ++t2)
#pragma unroll
            for (int j = 0; j < 8; ++j) xc[t2][j] = xq[t2][j];
        if (g0 + 16 < rpw) {
#pragma unroll
            for (int t2 = 0; t2 < 2; ++t2) { const int lrn = g0 + 16 + 2 * F.wave + t2; const int rown = row_of((lrn < rpw) ? lrn : 0);
#pragma unroll
                for (int j = 0; j < 8; ++j) xq[t2][j] = *(const v2u*)(XBp + (size_t)rown * D + 4 * F.lane + 256 * j); } }
#pragma unroll
        for (int t2 = 0; t2 < 2; ++t2) {
            const int tl = 2 * F.wave + t2, lr = g0 + tl; const bool valid = lr < rpw; const int row = row_of(valid ? lr : 0);
            const bool lat = row < TL; const int bidx = lat ? row / SEQ : 8;
            f32x4 v[8];
#pragma unroll
            for (int j = 0; j < 8; ++j) { const v2u t = xc[t2][j]; v[j] = (f32x4){bflo(t.x), bfhi(t.x), bflo(t.y), bfhi(t.y)}; }
            float ss = 0.f;
#pragma unroll
            for (int j = 0; j < 8; ++j) ss += (v[j].x * v[j].x + v[j].y * v[j].y) + (v[j].z * v[j].z + v[j].w * v[j].w);
            ss = wave_sum(ss);
            const float r = 1.0f / sqrtf(ss * (1.0f / D) + EPS);
#pragma unroll
            for (int jh = 0; jh < 2; ++jh) {
                f32x4 gmv[4], bv[4];
#pragma unroll
                for (int j4 = 0; j4 < 4; ++j4) { gmv[j4] = ((const LAS f32x4*)lm)[F.lane + 64 * (4 * jh + j4)]; bv[j4] = ((const LAS f32x4*)(lm + 2048))[F.lane + 64 * (4 * jh + j4)]; }
#pragma unroll
                for (int j4 = 0; j4 < 4; ++j4) { const int j = 4 * jh + j4;
                    const f32x4 gm = gmv[j4], b_ = bv[j4];
                    f32x4 hq; hq.x = (v[j].x * r) * gm.x + b_.x; hq.y = (v[j].y * r) * gm.y + b_.y; hq.z = (v[j].z * r) * gm.z + b_.z; hq.w = (v[j].w * r) * gm.w + b_.w;
                    if (valid) *(unsigned*)(H2 + (size_t)row * D + 4 * F.lane + 256 * j) = fp8x4(hq.x * S_ACT, hq.y * S_ACT, hq.z * S_ACT, hq.w * S_ACT);
                    else hq = (f32x4){0.f, 0.f, 0.f, 0.f};
                    *(LAS f32x4*)(frag + ((F.lane + 64 * j) * 16 + (tl ^ (F.lane & 15))) * 16) = hq;
                }
            }
        }
        LBAR(); RP_END(1);
        { f32x4 acc = (f32x4){0.f, 0.f, 0.f, 0.f};
          const LAS unsigned char* ap = frag + (64 * F.wave) * 256 + (F.lane >> 4) * 4; const int tsl = (F.lane & 15) * 16;
#pragma unroll
          for (int q = 0; q < 64; ++q) { int t_ = tsl; asm volatile("" : "+v"(t_));
              acc = __builtin_amdgcn_mfma_f32_16x16x4f32(*(const LAS float*)(ap + q * 256 + (t_ ^ ((q & 15) * 16))), wb[q], acc, 0, 0, 0); }
#pragma unroll
          for (int rg = 0; rg < 4; ++rg) part[(F.wave * 16 + 4 * (F.lane >> 4) + rg) * 16 + (F.lane & 15)] = acc[rg]; }
        LBAR(); RP_END(2);
        if (F.wave == 0 && F.lane < 16 && g0 + F.lane < rpw) {
            const int tl = F.lane, row = row_of(g0 + tl);
            float sel[16], sco[16];
#pragma unroll
            for (int e = 0; e < 16; ++e) { float lg = 0.f;
#pragma unroll
                for (int w = 0; w < 8; ++w) lg += part[(w * 16 + tl) * 16 + e];
                sco[e] = __builtin_amdgcn_rcpf(1.0f + __expf(-lg)); sel[e] = sco[e] + F.p->in[I_RBIAS][e]; }
            float bestv = 0.f; int best = 0;
#pragma unroll
            for (int g = 0; g < 4; ++g) {
                const float a_ = sel[4 * g], b_ = sel[4 * g + 1], c_ = sel[4 * g + 2], d_ = sel[4 * g + 3];
                const float hi1 = fmaxf(a_, b_), lo1 = fminf(a_, b_), hi2 = fmaxf(c_, d_), lo2 = fminf(c_, d_);
                const float gs = fmaxf(hi1, hi2) + fmaxf(fminf(hi1, hi2), fmaxf(lo1, lo2));
                if (g == 0 || gs > bestv) { bestv = gs; best = g; }
            }
            float cs[4], ss4[4];
#pragma unroll
            for (int k = 0; k < 4; ++k) { cs[k] = best == 0 ? sel[k] : best == 1 ? sel[4 + k] : best == 2 ? sel[8 + k] : sel[12 + k]; ss4[k] = best == 0 ? sco[k] : best == 1 ? sco[4 + k] : best == 2 ? sco[8 + k] : sco[12 + k]; }
            int k1 = 0; float v1 = cs[0], s1 = ss4[0];
#pragma unroll
            for (int k = 1; k < 4; ++k) if (cs[k] > v1) { v1 = cs[k]; k1 = k; s1 = ss4[k]; }
            int k2 = -1; float v2 = 0.f, s2v = 0.f;
#pragma unroll
            for (int k = 0; k < 4; ++k) if (k != k1 && (k2 < 0 || cs[k] > v2)) { v2 = cs[k]; k2 = k; s2v = ss4[k]; }
            const int a = (g0 + tl) * 2; const float inv = 1.0f / (s1 + s2v);
            asg_e[a] = best * 4 + k1; asg_w[a] = s1 * inv; asg_r[a] = row;
            asg_e[a + 1] = best * 4 + k2; asg_w[a + 1] = s2v * inv; asg_r[a + 1] = row;
        }
        LBAR(); RP_END(4);
    }
    __syncthreads();
    if (F.tid < NE) {
        const int e = F.tid; int cn = 0;
        for (int a = 0; a < 272; ++a) cn += (asg_e[a] == e) ? 1 : 0;
        ((int*)(F.ws + WS_LIST + LIST_CT))[F.bid * NE + e] = cn;
    }
}
DI void router_assign(Frame& F, int l) {
    LAS int* asg_e = (LAS int*)(F.lds + LC_SCR); LAS float* asg_w = (LAS float*)(F.lds + LC_SCR + 1088); LAS int* asg_r = (LAS int*)(F.lds + LC_SCR + 2176);
    LAS int* tab = (LAS int*)F.lds;
    const int* gtab = (const int*)(F.ws + WS_LIST + LIST_CT);
    for (int i = F.tid; i < F.G * NE; i += 512) tab[i] = gtab[i];
    __syncthreads();
    if (F.tid < NE) {
        const int e = F.tid; int base = 0, tot = 0;
        for (int w = 0; w < F.G; ++w) { const int c = tab[w * NE + e]; tot += c; base += (w < F.bid) ? c : 0; }
        if (F.bid == F.G - 1) __hip_atomic_store(F.ctl + CW_CNT + (l * 16 + e) * 64, (unsigned)tot, __ATOMIC_RELAXED, __HIP_MEMORY_SCOPE_AGENT);
        int run = base;
        int* rowlist = (int*)(F.ws + WS_LIST + LIST_ROW); float* wlist = (float*)(F.ws + WS_LIST + LIST_W); int* tokslot = (int*)(F.ws + WS_LIST + LIST_TS);
        for (int a = 0; a < 272; ++a) if (asg_e[a] == e) { const int row = asg_r[a]; rowlist[(size_t)e * ECAP + run] = row; wlist[(size_t)e * ECAP + run] = asg_w[a]; tokslot[row * 2 + (a & 1)] = (e << 20) | run; ++run; }
    }
    __syncthreads();
}

DI void qk_unit(Frame& F, int l, int unit) {
    bf16* U = WSP(bf16, WS_U);
    const int j8 = F.lane & 7;
    float qg[8], kg[8];
#pragma unroll
    for (int e = 0; e < 8; ++e) { qg[e] = F.p->in[I_QNG][l * 64 + 8 * j8 + e]; kg[e] = F.p->in[I_KNG][l * 64 + 8 * j8 + e]; }
    const LAS float* rt = (const LAS float*)(F.lds + LDS_MODV);
    const bool isrow = (j8 & 3) < 2, lohalf = j8 < 4;
    const int lnk = F.lane & 15;
#pragma unroll 1
    for (int trip = 0; trip < 2; ++trip) {
        const int rowb = unit * 64 + F.wave * 8 + trip * 4;
        const bool doq = (rowb < TL) || (l == 0);
        v4u vq[4], vk[4];
#pragma unroll
        for (int t = 0; t < 4; ++t) { const size_t ro = (size_t)(rowb + t) * INC;
            vq[t] = (v4u){0u, 0u, 0u, 0u}; if (doq) vq[t] = *(const v4u*)(U + ro + U_Q + 8 * F.lane);
            vk[t] = *(const v4u*)(U + ro + U_K + 8 * lnk); }
#pragma unroll
        for (int t = 0; t < 4; ++t) {
            const int row = rowb + t; const bool lat = row < TL;
            float cs[8], sn[8];
            if (lat) { const int tt = row % SEQ; const int pos = isrow ? (tt / 64) : (tt % 64); const LAS float* tp = rt + pos * 16 + 8 * (j8 & 1);
                const f32x4 c0 = *(const LAS f32x4*)tp, c1 = *(const LAS f32x4*)(tp + 4), s0 = *(const LAS f32x4*)(tp + 1024), s1 = *(const LAS f32x4*)(tp + 1028);
                cs[0] = c0.x; cs[1] = c0.y; cs[2] = c0.z; cs[3] = c0.w; cs[4] = c1.x; cs[5] = c1.y; cs[6] = c1.z; cs[7] = c1.w;
                sn[0] = s0.x; sn[1] = s0.y; sn[2] = s0.z; sn[3] = s0.w; sn[4] = s1.x; sn[5] = s1.y; sn[6] = s1.z; sn[7] = s1.w; }
#pragma unroll
            for (int part = 0; part < 2; ++part) {
                if (part == 0 && !doq) continue;
                bf16* p = U + (size_t)row * INC + (part ? U_K : U_Q) + 8 * (part ? lnk : F.lane);
                const v4u v = part ? vk[t] : vq[t];
                float x[8] = {bflo(v.x), bfhi(v.x), bflo(v.y), bfhi(v.y), bflo(v.z), bfhi(v.z), bflo(v.w), bfhi(v.w)};
                float ss = 0.f;
#pragma unroll
                for (int e = 0; e < 8; ++e) ss += x[e] * x[e];
                ss += sx<1>(ss); ss += sx<2>(ss); ss += sx<4>(ss);
                const float r = __builtin_amdgcn_rsqf(ss * (1.0f / 64.0f) + EPS);
                float o[8];
#pragma unroll
                for (int e = 0; e < 8; ++e) { const float xn = (x[e] * r) * (part ? kg[e] : qg[e]); float ov = xn;
                    if (lat) { const float pr = sx<4>(xn); ov = lohalf ? (xn * cs[e] - pr * sn[e]) : (pr * sn[e] + xn * cs[e]); }
                    o[e] = ov; }
                v4u w; w.x = cvt_pk_bf16(o[0], o[1]); w.y = cvt_pk_bf16(o[2], o[3]); w.z = cvt_pk_bf16(o[4], o[5]); w.w = cvt_pk_bf16(o[6], o[7]);
                if (part == 0 || F.lane < 16) *(v4u*)p = w;
            }
        }
    }
}

#if PROBE_CV
#define CP_T0() unsigned long long cp_t_ = __builtin_amdgcn_s_memrealtime()
#define CP_END(bit) do { const unsigned long long t1_ = __builtin_amdgcn_s_memrealtime(); if (PROBE_CV & (bit)) { const unsigned long long dt_ = t1_ - cp_t_; while (__builtin_amdgcn_s_memrealtime() - t1_ < dt_) __builtin_amdgcn_s_sleep(4); } cp_t_ = __builtin_amdgcn_s_memrealtime(); } while (0)
#else
#define CP_T0() do { } while (0)
#define CP_END(bit) do { } while (0)
#endif
DI void conv_unit(Frame& F, int l, int cu) {
    const bf16* U = WSP(bf16, WS_U); bf16* BR = WSP(bf16, WS_BR);
    LAS float* Y = (LAS float*)F.lds;
    const int r0 = cu * 32;
    CP_T0();
    const int seq_lo = (r0 < TL) ? (r0 / SEQ) * SEQ : TL + ((r0 - TL) / CTX) * CTX, seq_hi = seq_lo + ((r0 < TL) ? SEQ : CTX);
    const int c = F.tid; float w[31];
    const float* cw = F.p->in[I_CONVW] + (size_t)l * 31 * BRW;
#pragma unroll
    for (int j = 0; j < 31; ++j) w[j] = cw[j * BRW + c];
    const float bias = F.p->in[I_CONVB][l * BRW + c];
    { const int cv = F.tid & 63, rg = F.tid >> 6;
      v4u ur[8], gr[8];
#pragma unroll
      for (int j = 0; j < 8; ++j) { const int i = rg + 8 * j, row = r0 - 15 + i;
          ur[j] = (v4u){0u, 0u, 0u, 0u}; gr[j] = ur[j];
          if (i < 62 && row >= seq_lo && row < seq_hi) { ur[j] = *(const v4u*)(U + (size_t)row * INC + U_AU + 8 * cv); gr[j] = *(const v4u*)(U + (size_t)row * INC + U_AG + 8 * cv); } }
#pragma unroll
      for (int j = 0; j < 8; ++j) { const int i = rg + 8 * j; const v4u u = ur[j], g = gr[j];
          f32x4 y0, y1;
          y0.x = bflo(u.x) * sigmoidf_(bflo(g.x)); y0.y = bfhi(u.x) * sigmoidf_(bfhi(g.x)); y0.z = bflo(u.y) * sigmoidf_(bflo(g.y)); y0.w = bfhi(u.y) * sigmoidf_(bfhi(g.y));
          y1.x = bflo(u.z) * sigmoidf_(bflo(g.z)); y1.y = bfhi(u.z) * sigmoidf_(bfhi(g.z)); y1.z = bflo(u.w) * sigmoidf_(bflo(g.w)); y1.w = bfhi(u.w) * sigmoidf_(bfhi(g.w));
          if (i < 62) { *(LAS f32x4*)(Y + i * 512 + 8 * cv) = y0; *(LAS f32x4*)(Y + i * 512 + 8 * cv + 4) = y1; } } }
    __syncthreads(); CP_END(1);
    {
      for (int tb = 0; tb < 4; ++tb) {
          float z[8];
#pragma unroll
          for (int k = 0; k < 8; ++k) z[k] = bias;
#pragma unroll
          for (int j = 0; j < 38; ++j) { const float yv = Y[(8 * tb + j) * 512 + c];
#pragma unroll
              for (int k = 0; k < 8; ++k) { const int tap = j - k; if (tap >= 0 && tap < 31) z[k] += w[tap] * yv; } }
#pragma unroll
          for (int k = 0; k < 8; ++k) Y[(8 * tb + k) * 512 + c] = z[k];
      } }
    __syncthreads(); CP_END(2);
    { const float* lg = F.p->in[I_CLNG] + l * BRW + 8 * F.lane; const float* lb = F.p->in[I_CLNB] + l * BRW + 8 * F.lane;
      const f32x4 g0 = *(const f32x4*)lg, g1 = *(const f32x4*)(lg + 4), b0 = *(const f32x4*)lb, b1 = *(const f32x4*)(lb + 4);
      for (int tk = F.wave; tk < 32; tk += 8) {
          f32x4 a = *(const LAS f32x4*)(Y + tk * 512 + 8 * F.lane), b = *(const LAS f32x4*)(Y + tk * 512 + 8 * F.lane + 4);
          const float mu = wave_sum((a.x + a.y) + (a.z + a.w) + (b.x + b.y) + (b.z + b.w)) * (1.0f / 512.0f);
          a = a - mu; b = b - mu;
          const float var = wave_sum((a.x * a.x + a.y * a.y) + (a.z * a.z + a.w * a.w) + (b.x * b.x + b.y * b.y) + (b.z * b.z + b.w * b.w)) * (1.0f / 512.0f);
          const float rs = 1.0f / sqrtf(var + EPS);
          a = a * rs * g0 + b0; b = b * rs * g1 + b1;
          v4u o; o.x = pk2(siluf_(a.x), siluf_(a.y)); o.y = pk2(siluf_(a.z), siluf_(a.w)); o.z = pk2(siluf_(b.x), siluf_(b.y)); o.w = pk2(siluf_(b.z), siluf_(b.w));
          *(v4u*)(BR + (size_t)(r0 + tk) * D + B_A + 8 * F.lane) = o;
      } }
    __syncthreads(); CP_END(4);
}

template <bool COMB> DI void pool_unit(Frame& F, int l, int pu) {
    const bf16* U = WSP(bf16, WS_U); bf16* BR = WSP(bf16, WS_BR);
    v4u cf[4], cr[4], cg[4];
    if (COMB) { const bf16* HF = WSP(bf16, WS_H); const bf16* HR = HF + (size_t)MT * BRW;
#pragma unroll
        for (int t = 0; t < 4; ++t) { const size_t ro = (size_t)(pu * 32 + F.wave + 8 * t);
            cf[t] = *(const v4u*)(HF + ro * BRW + 8 * F.lane); cr[t] = *(const v4u*)(HR + ro * BRW + 8 * F.lane);
            cg[t] = *(const v4u*)(U + ro * INC + U_RG + 8 * F.lane); } }
    LAS unsigned char* Pin = F.lds;
    LAS unsigned char* Yl = F.lds + 49152;
    const int r0 = pu * 32;
    const int seq_lo = (r0 < TL) ? (r0 / SEQ) * SEQ : TL + ((r0 - TL) / CTX) * CTX, seq_hi = seq_lo + ((r0 < TL) ? SEQ : CTX);
    { v4u pr[6];
#pragma unroll
      for (int j = 0; j < 6; ++j) { const int q = F.tid + 512 * j, i = q >> 6, cv = q & 63, row = r0 - 8 + i; pr[j] = (v4u){0u, 0u, 0u, 0u};
          if (q < 47 * 64 && row >= seq_lo && row < seq_hi) pr[j] = *(const v4u*)(U + (size_t)row * INC + U_P + 8 * cv); }
#pragma unroll
      for (int j = 0; j < 6; ++j) { const int q = F.tid + 512 * j, i = q >> 6, cv = q & 63;
          if (q < 47 * 64) *(LAS v4u*)(Pin + i * 1024 + cv * 16) = pr[j]; } }
    __syncthreads();
    { const int tk = F.tid >> 4, row = r0 + tk;
#pragma unroll
      for (int g = 0; g < 4; ++g) { const int cv = (F.tid & 15) + 16 * g, hw = 1 << g;
          const int lo = max(row - hw, seq_lo), hi = min(row + hw, seq_hi);
          float s[8];
#pragma unroll
          for (int k = 0; k < 8; ++k) s[k] = 0.f;
          for (int rr = lo; rr < hi; ++rr) { const v4u v = *(const LAS v4u*)(Pin + (rr - r0 + 8) * 1024 + cv * 16);
              s[0] += bflo(v.x); s[1] += bfhi(v.x); s[2] += bflo(v.y); s[3] += bfhi(v.y); s[4] += bflo(v.z); s[5] += bfhi(v.z); s[6] += bflo(v.w); s[7] += bfhi(v.w); }
          const float ic = 1.0f / (float)(hi - lo);
          const v4u c = *(const LAS v4u*)(Pin + (tk + 8) * 1024 + cv * 16);
          v4u o; o.x = pk2(s[0] * ic - bflo(c.x), s[1] * ic - bfhi(c.x)); o.y = pk2(s[2] * ic - bflo(c.y), s[3] * ic - bfhi(c.y));
          o.z = pk2(s[4] * ic - bflo(c.z), s[5] * ic - bfhi(c.z)); o.w = pk2(s[6] * ic - bflo(c.w), s[7] * ic - bfhi(c.w));
          *(LAS v4u*)(Yl + tk * 1040 + cv * 16) = o; } }
    __syncthreads();
    { const int g = F.wave >> 1, hf = F.wave & 1, fr = F.lane & 15, fq = F.lane >> 4;
      const bf16* WP = WSP(bf16, WS_SMALLW + SW_POOL);
      f32x4 acc[2][4];
#pragma unroll
      for (int m = 0; m < 2; ++m)
#pragma unroll
          for (int n = 0; n < 4; ++n) acc[m][n] = (f32x4){0.f, 0.f, 0.f, 0.f};
#pragma unroll
      for (int s = 0; s < 4; ++s) {
          bf16x8 ya[2], wb[4];
#pragma unroll
          for (int m = 0; m < 2; ++m) ya[m] = *(const LAS bf16x8*)(Yl + (m * 16 + fr) * 1040 + (g * 128 + s * 32 + 8 * fq) * 2);
#pragma unroll
          for (int n = 0; n < 4; ++n) wb[n] = *(const bf16x8*)(WP + (size_t)(g * 128 + hf * 64 + n * 16 + fr) * 128 + s * 32 + 8 * fq);
#pragma unroll
          for (int m = 0; m < 2; ++m)
#pragma unroll
              for (int n = 0; n < 4; ++n) acc[m][n] = __builtin_amdgcn_mfma_f32_16x16x32_bf16(wb[n], ya[m], acc[m][n], 0, 0, 0);
      }
      const float* ps = F.p->in[I_POOLS] + l * BRW;
#pragma unroll
      for (int m = 0; m < 2; ++m)
#pragma unroll
          for (int n = 0; n < 4; ++n) { const int col = g * 128 + hf * 64 + n * 16 + 4 * fq; const f32x4 sc = *(const f32x4*)(ps + col);
              v2u o; o.x = pk2(acc[m][n].x * sc.x, acc[m][n].y * sc.y); o.y = pk2(acc[m][n].z * sc.z, acc[m][n].w * sc.w);
#if DBG_POOLY
              o = *(const LAS v2u*)(Yl + (m * 16 + fr) * 1040 + col * 2);
#endif
              *(v2u*)(BR + (size_t)(r0 + m * 16 + fr) * D + B_D + col) = o; } }
    if (COMB) {
#pragma unroll
        for (int t = 0; t < 4; ++t) { const size_t row = (size_t)(pu * 32 + F.wave + 8 * t);
            v4u o; o.x = cvt_pk_bf16((bflo(cf[t].x) + bflo(cr[t].x)) * gelu_tanh(bflo(cg[t].x)), (bfhi(cf[t].x) + bfhi(cr[t].x)) * gelu_tanh(bfhi(cg[t].x)));
            o.y = cvt_pk_bf16((bflo(cf[t].y) + bflo(cr[t].y)) * gelu_tanh(bflo(cg[t].y)), (bfhi(cf[t].y) + bfhi(cr[t].y)) * gelu_tanh(bfhi(cg[t].y)));
            o.z = cvt_pk_bf16((bflo(cf[t].z) + bflo(cr[t].z)) * gelu_tanh(bflo(cg[t].z)), (bfhi(cf[t].z) + bfhi(cr[t].z)) * gelu_tanh(bfhi(cg[t].z)));
            o.w = cvt_pk_bf16((bflo(cf[t].w) + bflo(cr[t].w)) * gelu_tanh(bflo(cg[t].w)), (bfhi(cf[t].w) + bfhi(cr[t].w)) * gelu_tanh(bfhi(cg[t].w)));
            *(v4u*)(BR + row * D + B_B + 8 * F.lane) = o; }
    }
    __syncthreads();
}

#if PROBE_LRU
#define LP_T0() unsigned long long lp_t_ = __builtin_amdgcn_s_memrealtime()
#define LP_END(bit) do { const unsigned long long t1_ = __builtin_amdgcn_s_memrealtime(); if (PROBE_LRU & (bit)) { const unsigned long long dt_ = t1_ - lp_t_; while (__builtin_amdgcn_s_memrealtime() - t1_ < dt_) __builtin_amdgcn_s_sleep(4); } lp_t_ = __builtin_amdgcn_s_memrealtime(); } while (0)
#else
#define LP_T0() do { } while (0)
#define LP_END(bit) do { } while (0)
#endif
DI void lru_item(Frame& F, int l, int item) {
    const int b = item >> 4, h = (item >> 1) & 7, d = item & 1;
    const bf16* U = WSP(bf16, WS_U); bf16* BR = WSP(bf16, WS_BR); bf16* HF = WSP(bf16, WS_H); bf16* HR = HF + (size_t)MT * BRW;
    LAS float* XC = (LAS float*)F.lds;
    LAS float* A_ = (LAS float*)(F.lds + 34816);
    LAS float* B_ = (LAS float*)(F.lds + 69632);
    LAS float* CAR = (LAS float*)(F.lds + 104448);
    LAS float* CWL = (LAS float*)(F.lds + 108544);
    const int fr = F.lane & 15, fq = F.lane >> 4;
    if (F.tid < 320) CWL[F.tid] = (F.tid < 256) ? F.p->in[I_LCW][(size_t)l * 4 * BRW + (F.tid >> 6) * BRW + 64 * h + (F.tid & 63)] : F.p->in[I_LCB][l * BRW + 64 * h + (F.tid - 256)];
    __syncthreads();
    const bf16* WL = WSP(bf16, WS_SMALLW + SW_LRU);
    const int p1 = F.tid >> 2, cq1 = F.tid & 3;
#define LRU_TAPS(ci_) do { const int sg_ = (ci_) >= 2 ? 1 : 0, L_ = sg_ ? SEQ : CTX, r0_ = sg_ ? b * SEQ : TL + b * CTX, cb_ = ((ci_) - 2 * sg_) * 128; \
        const int ti_ = d ? (L_ - 1 - (cb_ + p1)) : (cb_ + p1); \
        _Pragma("unroll") for (int j = 0; j < 4; ++j) { const int tt_ = ti_ + j - 2; pu[j][0] = (v4u){0u, 0u, 0u, 0u}; pu[j][1] = pu[j][0]; \
            if (tt_ >= 0 && tt_ < L_) { const bf16* up_ = U + (size_t)(r0_ + tt_) * INC + U_RX + 64 * h + 16 * cq1; pu[j][0] = *(const v4u*)up_; pu[j][1] = *(const v4u*)(up_ + 8); } } } while (0)
    {
        bf16x8 wf[2][4][2];
#pragma unroll
        for (int q = 0; q < 2; ++q)
#pragma unroll
            for (int n = 0; n < 4; ++n)
#pragma unroll
                for (int s2 = 0; s2 < 2; ++s2) wf[q][n][s2] = *(const bf16x8*)(WL + ((size_t)((d * 2 + q) * 8 + h) * 64 + n * 16 + fr) * 64 + s2 * 32 + 8 * fq);
        float ba[4], bx[4], sp[4];
#pragma unroll
        for (int n = 0; n < 4; ++n) { const int ch = 64 * h + n * 16 + fr;
            ba[n] = F.p->in[I_LBA][(l * 2 + d) * BRW + ch]; bx[n] = F.p->in[I_LBX][(l * 2 + d) * BRW + ch];
            const float lam = F.p->in[I_LLAM][(l * 2 + d) * BRW + ch]; const float xl = __expf(-lam); sp[n] = (xl < 0.03f) ? xl * (1.0f - xl * (0.5f - xl * 0.33333333f)) : __logf(1.0f + xl); }
        float Hc = 0.f;
        v4u pu[4][2];
        LRU_TAPS(0);
#pragma unroll 1
        for (int ci = 0; ci < 34; ++ci) {
            const int seg = ci >= 2 ? 1 : 0, L = seg ? SEQ : CTX, row0 = seg ? b * SEQ : TL + b * CTX, cb = (ci - 2 * seg) * 128;
            const bool wr_out = (seg == 1) || (l == 0);
            LP_T0();

            { float xc[16];
#pragma unroll
              for (int k = 0; k < 16; ++k) xc[k] = CWL[256 + 16 * cq1 + k];
#pragma unroll
              for (int j = 0; j < 4; ++j) { const LAS float* wj = CWL + j * 64 + 16 * cq1; const v4u u0 = pu[j][0], u1 = pu[j][1];
                  xc[0] += wj[0] * bflo(u0.x); xc[1] += wj[1] * bfhi(u0.x); xc[2] += wj[2] * bflo(u0.y); xc[3] += wj[3] * bfhi(u0.y);
                  xc[4] += wj[4] * bflo(u0.z); xc[5] += wj[5] * bfhi(u0.z); xc[6] += wj[6] * bflo(u0.w); xc[7] += wj[7] * bfhi(u0.w);
                  xc[8] += wj[8] * bflo(u1.x); xc[9] += wj[9] * bfhi(u1.x); xc[10] += wj[10] * bflo(u1.y); xc[11] += wj[11] * bfhi(u1.y);
                  xc[12] += wj[12] * bflo(u1.z); xc[13] += wj[13] * bfhi(u1.z); xc[14] += wj[14] * bflo(u1.w); xc[15] += wj[15] * bfhi(u1.w); }
#pragma unroll
              for (int k = 0; k < 16; k += 4) *(LAS f32x4*)(XC + p1 * 68 + 16 * cq1 + k) = (f32x4){xc[k], xc[k + 1], xc[k + 2], xc[k + 3]}; }
            if (ci + 1 < 34) LRU_TAPS(ci + 1);
            LBAR(); LP_END(1);
            { f32x4 da[4], dx[4];
#pragma unroll
              for (int n = 0; n < 4; ++n) { da[n] = (f32x4){0.f, 0.f, 0.f, 0.f}; dx[n] = da[n]; }
#pragma unroll
              for (int s2 = 0; s2 < 2; ++s2) {
                  const LAS float* xp = XC + (16 * F.wave + fr) * 68 + s2 * 32 + 8 * fq;
                  const f32x4 x0 = *(const LAS f32x4*)xp, x1 = *(const LAS f32x4*)(xp + 4);
                  v4u pk; pk.x = cvt_pk_bf16(x0.x, x0.y); pk.y = cvt_pk_bf16(x0.z, x0.w); pk.z = cvt_pk_bf16(x1.x, x1.y); pk.w = cvt_pk_bf16(x1.z, x1.w);
                  const bf16x8 xa = __builtin_bit_cast(bf16x8, pk);
#pragma unroll
                  for (int n = 0; n < 4; ++n) { da[n] = __builtin_amdgcn_mfma_f32_16x16x32_bf16(xa, wf[0][n][s2], da[n], 0, 0, 0); dx[n] = __builtin_amdgcn_mfma_f32_16x16x32_bf16(xa, wf[1][n][s2], dx[n], 0, 0, 0); }
              }
#pragma unroll
              for (int n = 0; n < 4; ++n) { const int ch = n * 16 + fr; f32x4 av4, bv4;
#pragma unroll
                  for (int rg = 0; rg < 4; ++rg) { const int p = 16 * F.wave + 4 * fq + rg;
                      const float xv = XC[p * 68 + ch];
                      const float r = __builtin_amdgcn_rcpf(1.0f + __expf(-(da[n][rg] + ba[n]))), ig = __builtin_amdgcn_rcpf(1.0f + __expf(-(dx[n][rg] + bx[n])));
                      const float la = -8.0f * r * sp[n];
                      const float av = __expf(la), e2 = av * av;
                      const float om = (la > -0.05f) ? (-2.0f * la) * (1.0f + la * (1.0f + la * 0.66666667f)) : (1.0f - e2);
                      av4[rg] = av; bv4[rg] = __builtin_amdgcn_sqrtf(om) * ig * xv; }
                  *(LAS f32x4*)(A_ + ch * 132 + 16 * F.wave + 4 * fq) = av4; *(LAS f32x4*)(B_ + ch * 132 + 16 * F.wave + 4 * fq) = bv4; } }
            LDS_WAIT(); LP_END(2);
            f32x4 a4[4], b4[4];
#pragma unroll
            for (int k = 0; k < 4; ++k) { a4[k] = *(const LAS f32x4*)(A_ + F.lane * 132 + 16 * F.wave + 4 * k); b4[k] = *(const LAS f32x4*)(B_ + F.lane * 132 + 16 * F.wave + 4 * k); }
            { float P = 1.f, hl = 0.f;
#pragma unroll
              for (int q = 0; q < 16; ++q) { const float a = a4[q >> 2][q & 3], bb = b4[q >> 2][q & 3]; hl = a * hl + bb; P *= a; }
              CAR[(F.wave * 64 + F.lane) * 2] = P; CAR[(F.wave * 64 + F.lane) * 2 + 1] = hl; }
            LBAR();
            float cin = Hc;
            { float c = Hc;
#pragma unroll
              for (int w = 0; w < 8; ++w) { if (w == F.wave) cin = c; c = CAR[(w * 64 + F.lane) * 2] * c + CAR[(w * 64 + F.lane) * 2 + 1]; }
              Hc = c; }
            LP_END(4);
            { float hh = cin;
              if (d == 0) {
#pragma unroll
                  for (int q = 0; q < 16; ++q) { const int p = 16 * F.wave + q; hh = a4[q >> 2][q & 3] * hh + b4[q >> 2][q & 3];
                      if (wr_out) HF[(size_t)(row0 + cb + p) * BRW + 64 * h + F.lane] = (bf16)f2bf(hh); }
              } else {
#pragma unroll
                  for (int q = 0; q < 16; ++q) { const int p = 16 * F.wave + q; hh = a4[q >> 2][q & 3] * hh + b4[q >> 2][q & 3];
                      if (wr_out) HR[(size_t)(row0 + (L - 1 - (cb + p))) * BRW + 64 * h + F.lane] = (bf16)f2bf(hh); }
              } }
            LP_END(8);
        }
        VM_WAIT(); __syncthreads();
    }
#undef LRU_TAPS
}


DI void attn_task(Frame& F, int l, int ta, LAS float* wl) {
    const bf16* U = WSP(bf16, WS_U); bf16* BR = WSP(bf16, WS_BR);
    const int qrow = ta >> 1, kvh = ta & 1;
    const bool lat = qrow < TL;
    const int b = lat ? qrow / SEQ : (qrow - TL) / CTX, t = lat ? qrow % SEQ : 0;
    LAS float* qs = wl;
    LAS float* pp = wl + 256;
#pragma unroll
    for (int g = 0; g < 4; ++g) qs[g * 64 + F.lane] = bf2f(U[(size_t)qrow * INC + U_Q + (kvh * 4 + g) * 64 + F.lane]);
    LDS_WAIT();
    float m0 = -1e30f, m1 = -1e30f, m2 = -1e30f, m3 = -1e30f;
#pragma unroll 1
    for (int rr = 0; rr < 9; ++rr) {
        const int ki = rr * 64 + F.lane; bool valid; size_t krow;
        if (ki < 256) { valid = true; krow = (size_t)(TL + b * CTX + ki); }
        else { const int s = t - 128 + (ki - 256); valid = lat && (ki - 256 <= 256) && s >= 0 && s < SEQ; krow = (size_t)(b * SEQ + (valid ? s : 0)); }
        float d0 = 0.f, d1 = 0.f, d2 = 0.f, d3 = 0.f;
        if (valid) {
            const bf16* kp = U + krow * INC + U_K + kvh * 64;
#pragma unroll
            for (int c8 = 0; c8 < 8; ++c8) { const v4u kv = *(const v4u*)(kp + 8 * c8);
                const float kf[8] = {bflo(kv.x), bfhi(kv.x), bflo(kv.y), bfhi(kv.y), bflo(kv.z), bfhi(kv.z), bflo(kv.w), bfhi(kv.w)};
#pragma unroll
                for (int hq = 0; hq < 2; ++hq) { const f32x4 q0 = *(const LAS f32x4*)(qs + 0 * 64 + 8 * c8 + 4 * hq), q1 = *(const LAS f32x4*)(qs + 1 * 64 + 8 * c8 + 4 * hq), q2 = *(const LAS f32x4*)(qs + 2 * 64 + 8 * c8 + 4 * hq), q3 = *(const LAS f32x4*)(qs + 3 * 64 + 8 * c8 + 4 * hq);
                    const float k0 = kf[4 * hq], k1 = kf[4 * hq + 1], k2 = kf[4 * hq + 2], k3 = kf[4 * hq + 3];
                    d0 += q0.x * k0 + q0.y * k1 + q0.z * k2 + q0.w * k3; d1 += q1.x * k0 + q1.y * k1 + q1.z * k2 + q1.w * k3;
                    d2 += q2.x * k0 + q2.y * k1 + q2.z * k2 + q2.w * k3; d3 += q3.x * k0 + q3.y * k1 + q3.z * k2 + q3.w * k3; } }
        }
        const f32x4 sv = valid ? (f32x4){d0 * 0.125f, d1 * 0.125f, d2 * 0.125f, d3 * 0.125f} : (f32x4){-1e30f, -1e30f, -1e30f, -1e30f};
        m0 = fmaxf(m0, sv.x); m1 = fmaxf(m1, sv.y); m2 = fmaxf(m2, sv.z); m3 = fmaxf(m3, sv.w);
        *(LAS f32x4*)(pp + ki * 4) = sv;
    }
    const float* sinkp = F.p->in[I_SINK] + l * 8 + kvh * 4;
    const float k0s = sinkp[0], k1s = sinkp[1], k2s = sinkp[2], k3s = sinkp[3];
    m0 = fmaxf(wave_max(m0), k0s); m1 = fmaxf(wave_max(m1), k1s); m2 = fmaxf(wave_max(m2), k2s); m3 = fmaxf(wave_max(m3), k3s);
    float s0 = 0.f, s1 = 0.f, s2 = 0.f, s3 = 0.f;
    LDS_WAIT();
#pragma unroll 1
    for (int rr = 0; rr < 9; ++rr) {
        const int ki = rr * 64 + F.lane; f32x4 sv = *(const LAS f32x4*)(pp + ki * 4);
        sv.x = (sv.x > -1e29f) ? __expf(sv.x - m0) : 0.f; sv.y = (sv.y > -1e29f) ? __expf(sv.y - m1) : 0.f; sv.z = (sv.z > -1e29f) ? __expf(sv.z - m2) : 0.f; sv.w = (sv.w > -1e29f) ? __expf(sv.w - m3) : 0.f;
        s0 += sv.x; s1 += sv.y; s2 += sv.z; s3 += sv.w;
        *(LAS f32x4*)(pp + ki * 4) = sv;
    }
    const float ri0 = 1.0f / (wave_sum(s0) + __expf(k0s - m0)), ri1 = 1.0f / (wave_sum(s1) + __expf(k1s - m1)), ri2 = 1.0f / (wave_sum(s2) + __expf(k2s - m2)), ri3 = 1.0f / (wave_sum(s3) + __expf(k3s - m3));
    LDS_WAIT();
    float o0 = 0.f, o1 = 0.f, o2 = 0.f, o3 = 0.f;
    { const bf16* vp = U + (size_t)(TL + b * CTX) * INC + U_V + kvh * 64 + F.lane;
#pragma unroll 4
      for (int ki = 0; ki < 256; ++ki) { const f32x4 p4 = *(const LAS f32x4*)(pp + ki * 4); const float v = bf2f(vp[(size_t)ki * INC]); o0 += p4.x * v; o1 += p4.y * v; o2 += p4.z * v; o3 += p4.w * v; } }
    if (lat) { const int slo = max(t - 128, 0), shi = min(t + 128, SEQ - 1);
        const bf16* vp = U + (size_t)(b * SEQ) * INC + U_V + kvh * 64 + F.lane;
#pragma unroll 4
        for (int s = slo; s <= shi; ++s) { const f32x4 p4 = *(const LAS f32x4*)(pp + (256 + s - t + 128) * 4); const float v = bf2f(vp[(size_t)s * INC]); o0 += p4.x * v; o1 += p4.y * v; o2 += p4.z * v; o3 += p4.w * v; } }
    bf16* op = BR + (size_t)qrow * D + B_C + (kvh * 4) * 64 + F.lane;
    op[0] = (bf16)f2bf(o0 * ri0); op[64] = (bf16)f2bf(o1 * ri1); op[128] = (bf16)f2bf(o2 * ri2); op[192] = (bf16)f2bf(o3 * ri3);
    LDS_WAIT();
}

typedef float f32x16 __attribute__((ext_vector_type(16)));
constexpr int AK_RS = 144, AV_RS = 656;
constexpr int AV_OFF = 320 * AK_RS;
template <bool COMB> DI void attn_unit(Frame& F, int l, int un) {
    const bf16* U = WSP(bf16, WS_U); bf16* BR = WSP(bf16, WS_BR);
    LAS unsigned char* Kl = F.lds; LAS unsigned char* Vt = F.lds + AV_OFF;
    const bool isctx = un >= 1024;
    int b, blk, kvh;
    if (!isctx) { b = un >> 7; blk = (un & 127) >> 1; kvh = un & 1; } else { const int u2 = un - 1024; b = u2 >> 3; blk = (u2 >> 1) & 3; kvh = u2 & 1; }
    const int t0 = blk * 64;
    const int g = F.wave & 3, th = F.wave >> 2, r = F.lane & 31, h = F.lane >> 5;
    const int thu = __builtin_amdgcn_readfirstlane(th);
    const int qtok = t0 + th * 32 + r;
    const size_t qrow = (size_t)(isctx ? TL + b * CTX : b * SEQ) + qtok;
    bf16x8 qf[4];
#pragma unroll
    for (int sp = 0; sp < 4; ++sp) { const v4u q4 = *(const v4u*)(U + qrow * INC + U_Q + (kvh * 4 + g) * 64 + 16 * sp + 8 * h);
        v4u o; o.x = pk2(bflo(q4.x) * 0.125f, bfhi(q4.x) * 0.125f); o.y = pk2(bflo(q4.y) * 0.125f, bfhi(q4.y) * 0.125f); o.z = pk2(bflo(q4.z) * 0.125f, bfhi(q4.z) * 0.125f); o.w = pk2(bflo(q4.w) * 0.125f, bfhi(q4.w) * 0.125f);
        qf[sp] = __builtin_bit_cast(bf16x8, o); }
    float m = F.p->in[I_SINK][l * 8 + kvh * 4 + g], lsum = 1.0f;
    f32x16 O0, O1;
#pragma unroll
    for (int i = 0; i < 16; ++i) { O0[i] = 0.f; O1[i] = 0.f; }
    const int nseg = isctx ? 1 : 2;
    v4u kreg[5], vra[3], vrb[3];
    auto issue = [&](int seg) {
        const int nk = seg ? 320 : 256, kbase = seg ? (t0 - 128) : 0, klim = seg ? SEQ : CTX;
        const size_t krow0 = seg ? (size_t)b * SEQ : (size_t)(TL + b * CTX);
#pragma unroll
        for (int j = 0; j < 5; ++j) { const int q = F.tid + 512 * j, key = q >> 3, c = q & 7, kt = kbase + key;
            kreg[j] = (v4u){0u, 0u, 0u, 0u};
            if (q < nk * 8 && kt >= 0 && kt < klim) kreg[j] = *(const v4u*)(U + (krow0 + kt) * INC + U_K + kvh * 64 + 8 * c); }
#pragma unroll
        for (int j = 0; j < 3; ++j) { const int q = F.tid + 512 * j, kp = q >> 3, c = q & 7, k0_ = kbase + 2 * kp, k1_ = k0_ + 1;
            vra[j] = (v4u){0u, 0u, 0u, 0u}; vrb[j] = vra[j];
            if (q < nk * 4 && k0_ >= 0 && k0_ < klim) vra[j] = *(const v4u*)(U + (krow0 + k0_) * INC + U_V + kvh * 64 + 8 * c);
            if (q < nk * 4 && k1_ >= 0 && k1_ < klim) vrb[j] = *(const v4u*)(U + (krow0 + k1_) * INC + U_V + kvh * 64 + 8 * c); }
    };
    auto commit = [&](int seg) {
        const int nk = seg ? 320 : 256;
#pragma unroll
        for (int j = 0; j < 5; ++j) { const int q = F.tid + 512 * j, key = q >> 3, c = q & 7;
            if (q < nk * 8) *(LAS v4u*)(Kl + key * AK_RS + c * 16) = kreg[j]; }
#pragma unroll
        for (int j = 0; j < 3; ++j) { const int q = F.tid + 512 * j, kp = q >> 3, c = q & 7;
            if (q < nk * 4) { const v4u va = vra[j], vb = vrb[j];
                LAS unsigned* vp = (LAS unsigned*)(Vt + (8 * c) * AV_RS + ((kp ^ ((c & 3) << 3)) * 4));
                vp[0] = (va.x & 0xffffu) | (vb.x << 16); vp[AV_RS / 4] = (va.x >> 16) | (vb.x & 0xffff0000u);
                vp[2 * (AV_RS / 4)] = (va.y & 0xffffu) | (vb.y << 16); vp[3 * (AV_RS / 4)] = (va.y >> 16) | (vb.y & 0xffff0000u);
                vp[4 * (AV_RS / 4)] = (va.z & 0xffffu) | (vb.z << 16); vp[5 * (AV_RS / 4)] = (va.z >> 16) | (vb.z & 0xffff0000u);
                vp[6 * (AV_RS / 4)] = (va.w & 0xffffu) | (vb.w << 16); vp[7 * (AV_RS / 4)] = (va.w >> 16) | (vb.w & 0xffff0000u); } }
    };
    v4u cf[4], cr[4], cg[4];
    const size_t crow0 = (size_t)(isctx ? TL + b * CTX : b * SEQ) + t0 + 32 * kvh;
    issue(0);
    for (int seg = 0; seg < nseg; ++seg) {
        const int nk = seg ? 320 : 256;
        const int kbase = seg ? (t0 - 128) : 0;
        commit(seg);
        if (seg + 1 < nseg) issue(seg + 1);
        if (COMB && seg + 1 == nseg) {
            const bf16* HF = WSP(bf16, WS_H); const bf16* HR = HF + (size_t)MT * BRW;
#pragma unroll
            for (int t = 0; t < 4; ++t) { const size_t ro = crow0 + (size_t)(F.wave + 8 * t);
                cf[t] = *(const v4u*)(HF + ro * BRW + 8 * F.lane); cr[t] = *(const v4u*)(HR + ro * BRW + 8 * F.lane);
                cg[t] = *(const v4u*)(U + ro * INC + U_RG + 8 * F.lane); } }
        LBAR();
        for (int kt = 0; kt < nk / 32; ++kt) {
            bool need_mask = false;
            if (seg) {
                const int rel = kt - thu, s0 = kbase + kt * 32;
                if (rel < 0 || rel > 8 || s0 < 0 || s0 >= SEQ) continue;
                need_mask = (rel == 0) || (rel == 8);
            }
            f32x16 S;
#pragma unroll
            for (int i = 0; i < 16; ++i) S[i] = 0.f;
#pragma unroll
            for (int sp = 0; sp < 4; ++sp) { const bf16x8 ka = *(const LAS bf16x8*)(Kl + (kt * 32 + r) * AK_RS + (16 * sp + 8 * h) * 2);
                S = __builtin_amdgcn_mfma_f32_32x32x16_bf16(ka, qf[sp], S, 0, 0, 0); }
            if (need_mask) {
#pragma unroll
                for (int i = 0; i < 16; ++i) { const int s_ = kbase + kt * 32 + (i & 3) + 8 * (i >> 2) + 4 * h; const int d_ = s_ - qtok;
                    if (d_ > 128 || d_ < -128) S[i] = -1e30f; }
            }
            float mx = S[0];
#pragma unroll
            for (int i = 1; i < 16; ++i) mx = fmaxf(mx, S[i]);
            mx = fmaxf(mx, sx<32>(mx));
            if (__builtin_amdgcn_ballot_w64(mx > m) != 0ull) {
                const float mn = fmaxf(m, mx), alpha = __builtin_amdgcn_exp2f((m - mn) * 1.44269504f);
                lsum *= alpha; m = mn;
#pragma unroll
                for (int i = 0; i < 16; ++i) { O0[i] *= alpha; O1[i] *= alpha; }
            }
            const float mnl = m * 1.44269504f;
            float ps = 0.f;
#pragma unroll
            for (int i = 0; i < 16; ++i) { S[i] = __builtin_amdgcn_exp2f(__builtin_fmaf(S[i], 1.44269504f, -mnl)); ps += S[i]; }
            ps += sx<32>(ps);
            lsum += ps;
            bf16x8 pb[2];
#pragma unroll
            for (int s2 = 0; s2 < 2; ++s2) { v4u o; o.x = cvt_pk_bf16(S[8 * s2 + 0], S[8 * s2 + 1]); o.y = cvt_pk_bf16(S[8 * s2 + 2], S[8 * s2 + 3]); o.z = cvt_pk_bf16(S[8 * s2 + 4], S[8 * s2 + 5]); o.w = cvt_pk_bf16(S[8 * s2 + 6], S[8 * s2 + 7]);
                pb[s2] = __builtin_bit_cast(bf16x8, o); }
#pragma unroll
            for (int s2 = 0; s2 < 2; ++s2) {
                const LAS unsigned char* vb = Vt + (((kt * 32 + 16 * s2 + 4 * h) * 2) ^ (((r >> 3) & 3) << 5));
                const v2u a0 = *(const LAS v2u*)(vb + r * AV_RS), a1 = *(const LAS v2u*)(vb + r * AV_RS + 16);
                const v2u c0 = *(const LAS v2u*)(vb + (32 + r) * AV_RS), c1 = *(const LAS v2u*)(vb + (32 + r) * AV_RS + 16);
                const bf16x8 va0 = __builtin_bit_cast(bf16x8, (v4u){a0.x, a0.y, a1.x, a1.y}), va1 = __builtin_bit_cast(bf16x8, (v4u){c0.x, c0.y, c1.x, c1.y});
                O0 = __builtin_amdgcn_mfma_f32_32x32x16_bf16(va0, pb[s2], O0, 0, 0, 0);
                O1 = __builtin_amdgcn_mfma_f32_32x32x16_bf16(va1, pb[s2], O1, 0, 0, 0);
            }
        }
        LBAR();
    }
    const float inv = 1.0f / lsum;
    bf16* op = BR + qrow * D + B_C + (kvh * 4 + g) * 64 + 4 * h;
#pragma unroll
    for (int q4 = 0; q4 < 4; ++q4) {
        v2u o0, o1; o0.x = cvt_pk_bf16(O0[4 * q4] * inv, O0[4 * q4 + 1] * inv); o0.y = cvt_pk_bf16(O0[4 * q4 + 2] * inv, O0[4 * q4 + 3] * inv);
        o1.x = cvt_pk_bf16(O1[4 * q4] * inv, O1[4 * q4 + 1] * inv); o1.y = cvt_pk_bf16(O1[4 * q4 + 2] * inv, O1[4 * q4 + 3] * inv);
        *(v2u*)(op + 8 * q4) = o0; *(v2u*)(op + 32 + 8 * q4) = o1;
    }
    if (COMB) {
#pragma unroll
        for (int t = 0; t < 4; ++t) { const size_t row = crow0 + (size_t)(F.wave + 8 * t);
            v4u o; o.x = cvt_pk_bf16((bflo(cf[t].x) + bflo(cr[t].x)) * gelu_tanh(bflo(cg[t].x)), (bfhi(cf[t].x) + bfhi(cr[t].x)) * gelu_tanh(bfhi(cg[t].x)));
            o.y = cvt_pk_bf16((bflo(cf[t].y) + bflo(cr[t].y)) * gelu_tanh(bflo(cg[t].y)), (bfhi(cf[t].y) + bfhi(cr[t].y)) * gelu_tanh(bfhi(cg[t].y)));
            o.z = cvt_pk_bf16((bflo(cf[t].z) + bflo(cr[t].z)) * gelu_tanh(bflo(cg[t].z)), (bfhi(cf[t].z) + bfhi(cr[t].z)) * gelu_tanh(bfhi(cg[t].z)));
            o.w = cvt_pk_bf16((bflo(cf[t].w) + bflo(cr[t].w)) * gelu_tanh(bflo(cg[t].w)), (bfhi(cf[t].w) + bfhi(cr[t].w)) * gelu_tanh(bfhi(cg[t].w)));
            *(v4u*)(BR + row * D + B_B + 8 * F.lane) = o; }
    }
}

DI void mixer_phase(Frame& F, int l, int part) {
    const int nrow_out = (l == 0) ? MT : TL;
    const int nA = (l == 0) ? 1088 : 1024, nC = nrow_out / 32, nP = nrow_out / 32, nQ = MT / 64;
    const int total = part ? nA : 128 + nP + nC + nQ;
    LAS int* qslot = (LAS int*)(F.lds + LC_SCR);
    if (part) {
        const int x = F.bid & 7, j = F.bid >> 3;
        for (int it = F.bid; it < total; it += F.G) { F.lane = lane_id_asm(); F.tid = F.wave * 64 + F.lane;
            const int un = (it < 1024 && F.G == 256) ? (it & ~255) + (x >> 2) * 128 + ((x & 1) * 32 + j) * 2 + ((x >> 1) & 1) : it;
            attn_unit<true>(F, l, un); __syncthreads(); }
        return;
    }
    if (!part) {
        LAS float* rt = (LAS float*)(F.lds + LDS_MODV);
        for (int i = F.tid; i < 1024; i += 512) { const float ang = (float)(i >> 4) * powf(10000.0f, -(float)(i & 15) * (1.0f / 16.0f)); rt[i] = __cosf(ang); rt[1024 + i] = __sinf(ang); }
        __syncthreads();
    }
    for (;;) {
        if (F.tid == 0) qslot[0] = (int)__hip_atomic_fetch_add(F.ctl + CW_QUEUE + l * 64 + part * 16, 1u, __ATOMIC_RELAXED, __HIP_MEMORY_SCOPE_AGENT);
        __syncthreads();
        const int it = qslot[0];
        __syncthreads();
        if (it >= total) break;
        F.lane = lane_id_asm(); F.tid = F.wave * 64 + F.lane;
        if (part) attn_unit<true>(F, l, it);
        else if (it < 128) lru_item(F, l, it);
        else if (it < 128 + nP) pool_unit<false>(F, l, it - 128);
        else if (it < 128 + nP + nC) conv_unit(F, l, it - 128 - nP);
        else qk_unit(F, l, it - 128 - nP - nC);
        __syncthreads();
    }
}

DI int xcd_remap(int L, int total) { const int q = total / 8, r = total % 8, x = L % 8, off = L / 8; return (x < r ? x * (q + 1) : r * (q + 1) + (x - r) * q) + off; }

typedef f32x4 AccT[2][2][4][2];

struct SchedP2 {
    int G, c, nMmain, nmain, total, ldb_; const char* A; const char* B;
    DI bool next(int i, Unit& u) const {
        const int L = i * G + c; if (L >= total) return false;
        int pm, pn;
        if (L < nmain) pg8::tile_of(L, nMmain, INC / 256, pm, pn); else { const int r = L - nmain; pm = 128 + r / 3; pn = r % 3; }
        u.a = A + (size_t)pm * 256 * ldb_; u.b = B + (size_t)pn * 256 * ldb_; u.rows = nullptr; u.nvalid = 0; u.i0 = pm; u.i1 = pn; u.i2 = 0; u.i3 = 0; return true;
    }
};
struct SchedG {
    int G, c, nM, total; const char* A; const char* B;
    DI bool next(int i, Unit& u) const {
        const int L = i * G + c; if (L >= total) return false;
        int pm, pn; pg8::tile_of(L, nM, NGATE / 256, pm, pn);
        u.a = A + (size_t)pm * 256 * D; u.b = B + (size_t)pn * 256 * D; u.rows = nullptr; u.nvalid = 0; u.i0 = pm; u.i1 = pn; u.i2 = 0; u.i3 = 0; return true;
    }
};
struct EpiU {
    static constexpr bool PERM = true;
    bf16* U;
    DI bool operator()(AccT& acc, const Unit& u, int wr, int wc, int fr, int fq) const {
        const int row0 = u.i0 * 256 + wr * 64 + fr, pn = u.i1;
        bf16* base = U + pn * 256 + wc * 32 + 8 * fq;
#pragma unroll
        for (int ai = 0; ai < 2; ++ai)
#pragma unroll
            for (int m = 0; m < 4; ++m) { bf16* rowp = base + (size_t)(row0 + ai * 128 + m * 16) * INC;
#pragma unroll
                for (int bj = 0; bj < 2; ++bj) { const f32x4 v0 = acc[ai][bj][m][0] * (F8_WIN ? SC_GU : 1.0f), v1 = acc[ai][bj][m][1] * (F8_WIN ? SC_GU : 1.0f);
                    v4u w; w.x = cvt_pk_bf16(v0[0], v0[1]); w.y = cvt_pk_bf16(v0[2], v0[3]); w.z = cvt_pk_bf16(v1[0], v1[1]); w.w = cvt_pk_bf16(v1[2], v1[3]);
                    *(v4u*)(rowp + bj * 128) = w; } }
        return false;
    }
};
struct EpiG {
    static constexpr bool PERM = true;
    bf16* Gt; const float* bgate;
    DI bool operator()(AccT& acc, const Unit& u, int wr, int wc, int fr, int fq) const {
        const int row0 = u.i0 * 256 + wr * 64 + fr, colt = u.i1 * 256 + wc * 32 + 8 * fq;
        f32x4 bb[2][2];
#pragma unroll
        for (int bj = 0; bj < 2; ++bj) { bb[bj][0] = *(const f32x4*)(bgate + colt + bj * 128) * 1.44269504f + 7.99435344f; bb[bj][1] = *(const f32x4*)(bgate + colt + bj * 128 + 4) * 1.44269504f + 7.99435344f; }
        unsigned char* gp = (unsigned char*)Gt + (size_t)u.i1 * 256 + (wc * 4 + fq) * 16;
#pragma unroll
        for (int ai = 0; ai < 2; ++ai) {
#pragma unroll
            for (int m = 0; m < 4; ++m) {
                unsigned wq[2][2];
#pragma unroll
                for (int bj = 0; bj < 2; ++bj) {
                    f32x4 v0 = acc[ai][bj][m][0] * (-SC_GU * 1.44269504f) - bb[bj][0], v1 = acc[ai][bj][m][1] * (-SC_GU * 1.44269504f) - bb[bj][1];
#pragma unroll
                    for (int k = 0; k < 4; ++k) { v0[k] = fmaxf(__builtin_amdgcn_rcpf(__builtin_amdgcn_exp2f(v0[k]) + (1.0f / 255.0f)), 1.0f); v1[k] = fmaxf(__builtin_amdgcn_rcpf(__builtin_amdgcn_exp2f(v1[k]) + (1.0f / 255.0f)), 1.0f); }
                    unsigned w0 = 0u, w1 = 0u;
                    w0 = __builtin_amdgcn_cvt_pk_u8_f32(v0[0], 0, w0); w0 = __builtin_amdgcn_cvt_pk_u8_f32(v0[1], 1, w0); w0 = __builtin_amdgcn_cvt_pk_u8_f32(v0[2], 2, w0); w0 = __builtin_amdgcn_cvt_pk_u8_f32(v0[3], 3, w0);
                    w1 = __builtin_amdgcn_cvt_pk_u8_f32(v1[0], 0, w1); w1 = __builtin_amdgcn_cvt_pk_u8_f32(v1[1], 1, w1); w1 = __builtin_amdgcn_cvt_pk_u8_f32(v1[2], 2, w1); w1 = __builtin_amdgcn_cvt_pk_u8_f32(v1[3], 3, w1);
                    wq[bj][0] = w0; wq[bj][1] = w1;
                }
                *(v4u*)(gp + (size_t)(row0 + ai * 128 + m * 16) * NGATE) = (v4u){wq[0][0], wq[0][1], wq[1][0], wq[1][1]};
            }
            asm volatile("" ::: "memory");
        }
        return false;
    }
};

struct SchedP4 {
    int G, c, nM, ntiles; const char* A; const char* B;
    DI bool next(int i, Unit& u) const {
        const int j = i >> 2, kb = i & 3, L = j * G + c; if (L >= ntiles) return false;
        int pm, pn; pg8::tile_of(L, nM, 8, pm, pn);
        u.a = A + (size_t)pm * 256 * (D * 2) + kb * (BRW * 2); u.b = B + ((size_t)kb * D + pn * 256) * (BRW * 2); u.rows = nullptr; u.nvalid = 0; u.i0 = pm; u.i1 = pn; u.i2 = kb; u.i3 = 0; return true;
    }
};
struct EpiHorner {
    static constexpr bool PERM = true;
    const bf16* Gt; bf16* ACC;
    DI bool operator()(AccT& acc, const Unit& u, int wr, int wc, int fr, int fq) const {
        const int row0 = u.i0 * 256 + wr * 64 + fr, col0 = u.i1 * 256 + wc * 32 + 8 * fq, kb = u.i2;
        const unsigned char* gp = (const unsigned char*)Gt + (size_t)kb * D + (size_t)u.i1 * 256 + (wc * 4 + fq) * 16;
#pragma unroll
        for (int ai = 0; ai < 2; ++ai) {
            v4u g0v[4], g1v[4];
#pragma unroll
            for (int m = 0; m < 4; ++m) { const size_t row = (size_t)(row0 + ai * 128 + m * 16);
                g0v[m] = *(const v4u*)(gp + row * NGATE);
                g1v[m] = (kb < 3) ? *(const v4u*)(gp + row * NGATE + D) : (v4u){0x01010101u, 0x01010101u, 0x01010101u, 0x01010101u}; }
#pragma unroll
            for (int m = 0; m < 4; ++m) { const size_t row = (size_t)(row0 + ai * 128 + m * 16);
#pragma unroll
                for (int bj = 0; bj < 2; ++bj) {
                    const unsigned gx = bj ? g0v[m].z : g0v[m].x, gy = bj ? g0v[m].w : g0v[m].y, hx = bj ? g1v[m].z : g1v[m].x, hy = bj ? g1v[m].w : g1v[m].y;
                    float s[8] = {(float)(gx & 0xffu), (float)((gx >> 8) & 0xffu), (float)((gx >> 16) & 0xffu), (float)(gx >> 24), (float)(gy & 0xffu), (float)((gy >> 8) & 0xffu), (float)((gy >> 16) & 0xffu), (float)(gy >> 24)};
                    const float t[8] = {(float)(hx & 0xffu), (float)((hx >> 8) & 0xffu), (float)((hx >> 16) & 0xffu), (float)(hx >> 24), (float)(hy & 0xffu), (float)((hy >> 8) & 0xffu), (float)((hy >> 16) & 0xffu), (float)(hy >> 24)};
#pragma unroll
                    for (int k = 0; k < 8; ++k) { if (kb < 3) s[k] *= __builtin_amdgcn_rcpf(t[k]); else s[k] *= (1.0f / 255.0f); }
                    f32x4 v0 = acc[ai][bj][m][0], v1 = acc[ai][bj][m][1];
                    v0[0] *= s[0]; v0[1] *= s[1]; v0[2] *= s[2]; v0[3] *= s[3]; v1[0] *= s[4]; v1[1] *= s[5]; v1[2] *= s[6]; v1[3] *= s[7];
                    acc[ai][bj][m][0] = v0; acc[ai][bj][m][1] = v1;
                    if (kb == 3) { v4u w; w.x = cvt_pk_bf16(v0[0], v0[1]); w.y = cvt_pk_bf16(v0[2], v0[3]); w.z = cvt_pk_bf16(v1[0], v1[1]); w.w = cvt_pk_bf16(v1[2], v1[3]);
                        *(v4u*)(ACC + row * D + col0 + bj * 128) = w; }
                } }
            asm volatile("" ::: "memory");
        }
        return kb < 3;
    }
};

struct SchedP5 {
    int G, c, nM, ntiles; const char* A; const char* B;
    DI bool next(int i, Unit& u) const {
        const int L = i * G + c; if (L >= ntiles) return false;
        int pm, pn; pg8::tile_of(L, nM, 8, pm, pn);
        u.a = A + (size_t)pm * 256 * (F8_WOUT ? D : D * 2); u.b = B + (size_t)pn * 256 * (F8_WOUT ? D : D * 2); u.rows = nullptr; u.nvalid = 0; u.i0 = pm; u.i1 = pn; u.i2 = 0; u.i3 = 0; return true;
    }
};
template <bool SB> struct EpiRes {
    static constexpr bool PERM = true;
    const float* xl; const float* xc; bf16* XB; const float* modg;
    DI bool operator()(AccT& acc, const Unit& u, int wr, int wc, int fr, int fq) const {
        const int pm = u.i0; const bool lat = pm < 128; const int bidx = lat ? pm / 16 : 8;
        const float* src = lat ? xl + (size_t)pm * 256 * D : xc + (size_t)(pm - 128) * 256 * D;
        bf16* xb = XB + (size_t)pm * 256 * D;
        const int col0 = u.i1 * 256 + wc * 32 + 8 * fq, r0 = wr * 64 + fr;
        const float* g1 = modg + (size_t)bidx * MODW;
        f32x4 gv[2][2];
#pragma unroll
        for (int bj = 0; bj < 2; ++bj)
#pragma unroll
            for (int n = 0; n < 2; ++n) gv[bj][n] = *(const f32x4*)(g1 + col0 + bj * 128 + n * 4);
#pragma unroll
        for (int ai = 0; ai < 2; ++ai) {
            f32x4 bsv[4][2][2];
#pragma unroll
            for (int m = 0; m < 4; ++m) { const size_t off = (size_t)(r0 + ai * 128 + m * 16) * D + col0;
#pragma unroll
                for (int bj = 0; bj < 2; ++bj) {
                    if (SB) { const v4u t = *(const v4u*)(xb + off + bj * 128);
                        bsv[m][bj][0] = (f32x4){bflo(t.x), bfhi(t.x), bflo(t.y), bfhi(t.y)}; bsv[m][bj][1] = (f32x4){bflo(t.z), bfhi(t.z), bflo(t.w), bfhi(t.w)}; }
                    else { bsv[m][bj][0] = *(const f32x4*)(src + off + bj * 128); bsv[m][bj][1] = *(const f32x4*)(src + off + bj * 128 + 4); } } }
#pragma unroll
            for (int m = 0; m < 4; ++m) { const size_t off = (size_t)(r0 + ai * 128 + m * 16) * D + col0;
#pragma unroll
                for (int bj = 0; bj < 2; ++bj) {
                    const f32x4 v0 = bsv[m][bj][0] + gv[bj][0] * (acc[ai][bj][m][0] * (F8_WOUT ? SC_GU : 1.0f)), v1 = bsv[m][bj][1] + gv[bj][1] * (acc[ai][bj][m][1] * (F8_WOUT ? SC_GU : 1.0f));
                    v4u w; w.x = cvt_pk_bf16(v0[0], v0[1]); w.y = cvt_pk_bf16(v0[2], v0[3]); w.z = cvt_pk_bf16(v1[0], v1[1]); w.w = cvt_pk_bf16(v1[2], v1[3]);
                    *(v4u*)(xb + off + bj * 128) = w; } }
            asm volatile("" ::: "memory");
        }
        return false;
    }
};

struct SchedMoe {
    int G, c, NT, mode; const LAS int* tpre; const LAS int* cnt;
    const char* A; const char* B; const int* rowlist; int lda_b, ldb_b;
    DI bool next(int i, Unit& u) const {
        const int L0 = i * G + c; if (L0 >= NT * 8) return false;
        const int L = xcd_remap(L0, NT * 8);
        const int rt = L >> 3, ct = L & 7; int e = 0;
#pragma unroll
        for (int k = 1; k < NE; ++k) e += (tpre[k] <= rt) ? 1 : 0;
        e = __builtin_amdgcn_readfirstlane(e);
        const int rb = __builtin_amdgcn_readfirstlane(rt - tpre[e]);
        u.nvalid = __builtin_amdgcn_readfirstlane(min(256, cnt[e] - rb * 256)); u.rows = rowlist + (size_t)e * ECAP + rb * 256;
        if (mode == 0) { u.a = A; u.b = B + ((size_t)e * 2048 + ct * 256) * ldb_b; }
        else { u.a = A + (size_t)rt * 256 * lda_b; u.b = B + ((size_t)e * 2048 + ct * 256) * ldb_b; }
        u.i0 = rt; u.i1 = ct; u.i2 = e; u.i3 = rb; return true;
    }
};
struct EpiSwiglu {
    static constexpr bool PERM = true;
    unsigned char* HB;
    DI bool operator()(AccT& acc, const Unit& u, int wr, int wc, int fr, int fq) const {
        const int row0 = u.i0 * 256 + wr * 64 + fr, col0 = u.i1 * 128 + wc * 32 + 8 * fq;
#pragma unroll
        for (int ai = 0; ai < 2; ++ai)
#pragma unroll
            for (int m = 0; m < 4; ++m) {
                f32x4 g0 = acc[ai][0][m][0], g1 = acc[ai][0][m][1]; const f32x4 u0 = acc[ai][1][m][0], u1 = acc[ai][1][m][1];
#pragma unroll
                for (int k = 0; k < 4; ++k) { const float a0 = g0[k] * SC_GU, a1 = g1[k] * SC_GU; g0[k] = a0 * __builtin_amdgcn_rcpf(1.0f + __expf(-a0)) * (u0[k] * SC_GU); g1[k] = a1 * __builtin_amdgcn_rcpf(1.0f + __expf(-a1)) * (u1[k] * SC_GU); }
                v2u w; w.x = fp8x4(g0[0] * S_HB, g0[1] * S_HB, g0[2] * S_HB, g0[3] * S_HB); w.y = fp8x4(g1[0] * S_HB, g1[1] * S_HB, g1[2] * S_HB, g1[3] * S_HB);
                *(v2u*)(HB + (size_t)(row0 + ai * 128 + m * 16) * DE + col0) = w; }
        return false;
    }
};
struct EpiDown {
    static constexpr bool PERM = true;
    bf16* O; const float* wlist;
    DI bool operator()(AccT& acc, const Unit& u, int wr, int wc, int fr, int fq) const {
        const int rl0 = wr * 64 + fr, col0 = u.i1 * 256 + wc * 32 + 8 * fq;
        const float* wp = wlist + (size_t)u.i2 * ECAP + u.i3 * 256;
#pragma unroll
        for (int ai = 0; ai < 2; ++ai)
#pragma unroll
            for (int m = 0; m < 4; ++m) { const int rl = rl0 + ai * 128 + m * 16; const float w = rl < u.nvalid ? wp[rl] * SC_DN : 0.f;
                bf16* rowp = O + (size_t)(u.i0 * 256 + rl) * D + col0;
#pragma unroll
                for (int bj = 0; bj < 2; ++bj) { const f32x4 v0 = acc[ai][bj][m][0] * w, v1 = acc[ai][bj][m][1] * w;
                    v4u q; q.x = cvt_pk_bf16(v0[0], v0[1]); q.y = cvt_pk_bf16(v0[2], v0[3]); q.z = cvt_pk_bf16(v1[0], v1[1]); q.w = cvt_pk_bf16(v1[2], v1[3]);
                    *(v4u*)(rowp + bj * 128) = q; } }
        return false;
    }
};


DI void dbg_checksum(Frame& F, const unsigned* p, size_t nwords, unsigned* cs) {
    unsigned h = 0;
    for (size_t i = (size_t)F.bid * 512 + F.tid; i < nwords; i += (size_t)F.G * 512) h += p[i] * 2654435761u + (unsigned)i;
    __hip_atomic_fetch_add(cs, h, __ATOMIC_RELAXED, __HIP_MEMORY_SCOPE_AGENT);
}
constexpr int NPH = 20;
#if MK_PER_PHASE
#define GRID_BAR() do { } while (0)
#else
#define GRID_BAR() xcd_barrier(bar)
#endif
#define IN(k) (lo <= (k) && (k) < hi)
#define PB() do { F.lane = lane_id_asm(); F.tid = F.wave * 64 + F.lane; { const __attribute__((address_space(4))) char* ka_ = (const __attribute__((address_space(4))) char*)__builtin_amdgcn_kernarg_segment_ptr(); asm volatile("" : "+s"(ka_)); F.p = (const __attribute__((address_space(4))) Params*)ka_; } } while (0)
#define SEAM(k) do { if (IN(k) && IN((k) + 1)) GRID_BAR(); } while (0)
#if PROBE_MASK
#define PR_BEGIN() do { pr_t0 = __builtin_amdgcn_s_memrealtime(); } while (0)
#define PR_END(j) do { if ((PROBE_MASK >> (j)) & 1) { const unsigned long long t1_ = __builtin_amdgcn_s_memrealtime(); const unsigned long long dt_ = t1_ - pr_t0; while (__builtin_amdgcn_s_memrealtime() - t1_ < dt_) __builtin_amdgcn_s_sleep(8); } } while (0)
#else
#define PR_BEGIN() do { } while (0)
#define PR_END(j) do { } while (0)
#endif
template <int l> DI void run_layer(Frame& F, const XcdBarrier& bar, const int lo, const int hi, unsigned long long& pr_t0) {
    LAS unsigned char* ring = F.lds; const float* mod = WSP(float, WS_MOD);
    constexpr int pb = 1 + 9 * l; PR_BEGIN();
        if (IN(pb + 0)) { PB(); norm_phase(F, l, l == 0 ? 0 : 1); PB(); if (l > 0) convert_weights(F, l); }
        SEAM(pb + 0); PR_END(1); PR_BEGIN();
        if (IN(pb + 1)) {
            { SchedP2 S; S.G = F.G; S.c = F.bid; S.nMmain = (l == 0) ? 136 : 128; S.nmain = S.nMmain * (INC / 256); S.total = S.nmain + ((l == 0) ? 0 : 24);
#if F8_WIN
              S.A = (const char*)WSP(unsigned char, WS_H8); S.B = (const char*)WSP(unsigned char, WS_W2); S.ldb_ = D;
              EpiU E; E.U = WSP(bf16, WS_U);
              pg8::gemm_phase<EpiU, SchedP2, false, true>(ring, F.wave, D / 2, D, D, S, E); }
#else
              S.A = (const char*)WSP(bf16, WS_H); S.B = (const char*)WSP(bf16, WS_W2); S.ldb_ = D * 2;
              EpiU E; E.U = WSP(bf16, WS_U);
              pg8::gemm_phase<EpiU, SchedP2, false, false>(ring, F.wave, D, D * 2, D * 2, S, E); }
#endif
            { SchedG S; S.G = F.G; S.c = F.bid; S.nM = (l == 0) ? 136 : 128; S.total = S.nM * (NGATE / 256);
              S.A = (const char*)WSP(unsigned char, WS_H8); S.B = (const char*)WSP(unsigned char, WS_W2) + W2G_OFF;
              EpiG E; E.Gt = WSP(bf16, WS_G); E.bgate = F.p->in[I_BGATE] + (size_t)l * NGATE;
              pg8::gemm_phase<EpiG, SchedG, false, true>(ring, F.wave, D / 2, D, D, S, E); }
        }
        SEAM(pb + 1); PR_END(2); PR_BEGIN();
        PR_END(3); PR_BEGIN();
        if (IN(pb + 3)) { PB();
#if PROBE_MX
            unsigned long long mx_t_ = __builtin_amdgcn_s_memrealtime();
#define MX_END(bit) do { const unsigned long long t1_ = __builtin_amdgcn_s_memrealtime(); if (PROBE_MX & (bit)) { const unsigned long long dt_ = t1_ - mx_t_; while (__builtin_amdgcn_s_memrealtime() - t1_ < dt_) __builtin_amdgcn_s_sleep(4); } mx_t_ = __builtin_amdgcn_s_memrealtime(); } while (0)
#else
#define MX_END(bit) do { } while (0)
#endif
            mixer_phase(F, l, 0); MX_END(1); GRID_BAR(); MX_END(2); PB(); mixer_phase(F, l, 1); MX_END(4); }
        SEAM(pb + 3); PR_END(4); PR_BEGIN();
        const int nM = (l == 0) ? 136 : 128;
        if (IN(pb + 4)) {
            SchedP4 S; S.G = F.G; S.c = F.bid; S.nM = nM; S.ntiles = nM * 8; S.A = (const char*)WSP(bf16, WS_BR); S.B = (const char*)WSP(bf16, WS_WB);
            EpiHorner E; E.Gt = WSP(bf16, WS_G); E.ACC = WSP(bf16, WS_U);
            pg8::gemm_phase<EpiHorner, SchedP4, false, false>(ring, F.wave, BRW, D * 2, BRW * 2, S, E);
        }
        SEAM(pb + 4); PR_END(5); PR_BEGIN();
        if (IN(pb + 5)) {
            SchedP5 S; S.G = F.G; S.c = F.bid; S.nM = nM; S.ntiles = nM * 8; S.A = (const char*)WSP(bf16, WS_U); S.B = (const char*)WSP(bf16, WS_WO);
            EpiRes<(l > 0)> E; E.xl = F.p->in[I_X]; E.xc = F.p->in[I_CTX]; E.XB = WSP(bf16, WS_XB); E.modg = mod + (size_t)l * 9 * MODW + MO_G1;
#if F8_WOUT
            pg8::gemm_phase<EpiRes<(l > 0)>, SchedP5, false, true>(ring, F.wave, D / 2, D, D, S, E);
#else
            pg8::gemm_phase<EpiRes<(l > 0)>, SchedP5, false, false>(ring, F.wave, D, D * 2, D * 2, S, E);
#endif
        }
        SEAM(pb + 5); PR_END(6); PR_BEGIN();
        if (IN(pb + 6)) { PB(); router_phase(F, l); GRID_BAR(); PB(); router_assign(F, l); }
        SEAM(pb + 6); PR_END(7); PR_BEGIN();
        if (IN(pb + 7)) {
            PB();
            LAS int* tpre = (LAS int*)(F.lds + LC_SCR + 4096); LAS int* cn = tpre + 32;
            if (F.tid == 0) { int acc = 0; for (int e = 0; e < NE; ++e) { const int c = (int)__hip_atomic_load(F.ctl + CW_CNT + (l * 16 + e) * 64, __ATOMIC_RELAXED, __HIP_MEMORY_SCOPE_AGENT); cn[e] = c; tpre[e] = acc; acc += (c + 255) >> 8; } tpre[NE] = acc; }
            __syncthreads();
            SchedMoe S; S.G = F.G; S.c = F.bid; S.NT = __builtin_amdgcn_readfirstlane(tpre[NE]); S.tpre = tpre; S.cnt = cn; S.rowlist = (const int*)(F.ws + WS_LIST + LIST_ROW);
            S.mode = 0; S.A = (const char*)WSP(unsigned char, WS_H); S.B = (const char*)WSP(unsigned char, WS_WGU); S.lda_b = D; S.ldb_b = D;
            EpiSwiglu E; E.HB = WSP(unsigned char, WS_HB);
            pg8::gemm_phase<EpiSwiglu, SchedMoe, true, true>(ring, F.wave, D / 2, D, D, S, E);
        }
        SEAM(pb + 7); PR_END(8); PR_BEGIN();
        if (IN(pb + 8)) {
            PB();
            LAS int* tpre = (LAS int*)(F.lds + LC_SCR + 4096); LAS int* cn = tpre + 32;
            if (F.tid == 0) { int acc = 0; for (int e = 0; e < NE; ++e) { const int c = (int)__hip_atomic_load(F.ctl + CW_CNT + (l * 16 + e) * 64, __ATOMIC_RELAXED, __HIP_MEMORY_SCOPE_AGENT); cn[e] = c; tpre[e] = acc; acc += (c + 255) >> 8; } tpre[NE] = acc; }
            __syncthreads();
            SchedMoe S; S.G = F.G; S.c = F.bid; S.NT = __builtin_amdgcn_readfirstlane(tpre[NE]); S.tpre = tpre; S.cnt = cn; S.rowlist = (const int*)(F.ws + WS_LIST + LIST_ROW);
            S.mode = 1; S.A = (const char*)WSP(unsigned char, WS_HB); S.B = (const char*)WSP(unsigned char, WS_WD); S.lda_b = DE; S.ldb_b = DE;
            EpiDown E; E.O = WSP(bf16, WS_O); E.wlist = (const float*)(F.ws + WS_LIST + LIST_W);
            pg8::gemm_phase<EpiDown, SchedMoe, false, true>(ring, F.wave, DE / 2, DE, DE, S, E);
        }
        SEAM(pb + 8); PR_END(9); PR_BEGIN();
    }

__global__ void __launch_bounds__(512, 2) mk_fwd(Params prm) {
    extern __shared__ __attribute__((aligned(16))) unsigned char lds_raw[];
    Frame F;
    F.lds = (LAS unsigned char*)lds_raw; F.p = (const __attribute__((address_space(4))) Params*)__builtin_amdgcn_kernarg_segment_ptr(); F.ws = prm.ws; F.ctl = (unsigned*)(prm.ws + WS_CTL);
    F.tid = threadIdx.x; F.lane = F.tid & 63; F.wave = __builtin_amdgcn_readfirstlane(F.tid >> 6); F.G = gridDim.x; F.bid = blockIdx.x;
    for (int u = F.tid; u < (LDS_BYTES - LDSCTL_OFF) / 4; u += 512) ((LAS unsigned*)(F.lds + LDSCTL_OFF))[u] = 0u;
    __syncthreads();
#if !MK_PER_PHASE
    XcdBarrier bar = xcd_barrier_post(F.ctl + CW_BAR, (volatile LAS unsigned*)(F.lds + LDSCTL_OFF));
#else
    XcdBarrier bar; bar.bar = nullptr; bar.x = 0; bar.st = nullptr;
#endif
    const int lo = prm.ph_lo, hi = prm.ph_hi;
    unsigned long long pr_t0 = 0; (void)pr_t0;
    LAS unsigned char* ring = F.lds;
    const float* mod = WSP(float, WS_MOD);

    PR_BEGIN();
    if (IN(0)) { PB(); mod_gemv(F); PB(); convert_weights(F, 0); }
    SEAM(0); PR_END(0);
    run_layer<0>(F, bar, lo, hi, pr_t0);
    run_layer<1>(F, bar, lo, hi, pr_t0);
    PR_BEGIN();
    if (IN(NPH - 1)) { PB(); norm_phase(F, DEPTH - 1, 2); }
    PR_END(10);
}

#ifndef DBG_DUMP
#endif
__global__ void dbg_dump(const bf16* a, const bf16* b, float* o, size_t n) {
    for (size_t i = (size_t)blockIdx.x * blockDim.x + threadIdx.x; i < n; i += (size_t)gridDim.x * blockDim.x) o[i] = bf2f(a[i]) + 3.0f * bf2f(b[i]);
}
__global__ void dbg_dump2(const bf16* br, int c0, int c1, float* o, size_t n) {
    for (size_t i = (size_t)blockIdx.x * blockDim.x + threadIdx.x; i < n; i += (size_t)gridDim.x * blockDim.x) { const size_t row = i >> 9; const int c = (int)(i & 511);
        o[i] = (row < (size_t)MT) ? bf2f(br[row * D + c0 + c]) + 3.0f * bf2f(br[row * D + c1 + c]) : 0.f; }
}
extern "C" void kernel_launch(void* const* d_in, const int* in_sizes, int n_in, void* d_out, int out_size, void* d_ws, size_t ws_size, hipStream_t stream) {
    static int grid = 0;
    if (grid == 0) {
        if (n_in != 34 || out_size != TL * D || ws_size < WS_END) { fprintf(stderr, "kernel_launch: unexpected shapes (n_in %d out %d ws %zu, need ws >= %zu)\n", n_in, out_size, ws_size, (size_t)WS_END); grid = -1; return; }
        int dev = 0, cus = 0, per_cu = 0;
        if (hipGetDevice(&dev) != hipSuccess || hipDeviceGetAttribute(&cus, hipDeviceAttributeMultiprocessorCount, dev) != hipSuccess) { grid = -1; return; }
        if (hipFuncSetAttribute((const void*)mk_fwd, hipFuncAttributeMaxDynamicSharedMemorySize, LDS_BYTES) != hipSuccess) { fprintf(stderr, "kernel_launch: hipFuncSetAttribute failed\n"); grid = -1; return; }
        if (hipOccupancyMaxActiveBlocksPerMultiprocessor(&per_cu, (const void*)mk_fwd, 512, LDS_BYTES) != hipSuccess || per_cu < 1) fprintf(stderr, "kernel_launch: occupancy query says %d\n", per_cu);
        (void)hipGetLastError();
        grid = cus;
        if (grid != 256) { fprintf(stderr, "kernel_launch: built for 256 CUs, device has %d\n", cus); grid = -1; return; }
    }
    if (grid < 0) return;
    (void)hipMemsetAsync((char*)d_ws + WS_CTL, 0, CTL_BYTES, stream);
    Params p{};
    for (int i = 0; i < 34; ++i) p.in[i] = (const float*)d_in[i];
    p.out = (float*)d_out; p.ws = (unsigned char*)d_ws;
#if MK_PER_PHASE
    for (int ph = 0; ph < DBG_PH_HI; ++ph) { p.ph_lo = ph; p.ph_hi = ph + 1; hipLaunchKernelGGL(mk_fwd, dim3(grid), dim3(512), LDS_BYTES, stream, p); }
#if DBG_DUMP == 1
    hipLaunchKernelGGL(dbg_dump, dim3(2048), dim3(256), 0, stream, (const bf16*)((char*)d_ws + WS_U), (const bf16*)((char*)d_ws + WS_G), (float*)d_out, (size_t)TL * D);
#endif
#else
    p.ph_lo = 0; p.ph_hi = DBG_PH_HI;
    hipLaunchKernelGGL(mk_fwd, dim3(grid), dim3(512), LDS_BYTES, stream, p);
#if DBG_DUMP == 1
    hipLaunchKernelGGL(dbg_dump, dim3(2048), dim3(256), 0, stream, (const bf16*)((char*)d_ws + WS_G), (const bf16*)((char*)d_ws + WS_U), (float*)d_out, (size_t)TL * D);
#endif
#if DBG_DUMP == 2
    hipLaunchKernelGGL(dbg_dump2, dim3(2048), dim3(256), 0, stream, (const bf16*)((char*)d_ws + WS_BR), DBG_BRSEL ? B_D : B_A, DBG_BRSEL ? B_D : B_B, (float*)d_out, (size_t)TL * D);
#endif
#endif
}
```

```cpp
#include <hip/hip_runtime.h>
#include <cstdio>
#include <cstdint>

#define DBG_DUMP 0
#ifndef G_U8
#define G_U8 1
#endif
#ifndef PROBE_MX
#define PROBE_MX 0
#endif
#ifndef PROBE_CV
#define PROBE_CV 0
#endif
#ifndef PROBE_RT
#define PROBE_RT 0
#endif
#ifndef F8_G
#define F8_G 0
#endif
#ifndef F8_WIN
#define F8_WIN 0
#endif
#ifndef F8_WOUT
#define F8_WOUT 0
#endif
#ifndef PROBE_LRU
#define PROBE_LRU 0
#endif
#ifndef PROBE_MIX
#define PROBE_MIX 0
#endif
#ifndef PROBE_MASK
#define PROBE_MASK 0
#endif
#define DBG_POOLY 0
#define DBG_BRSEL 1
#ifndef DBG_TWICE
#define DBG_TWICE 0
#endif
#ifndef GEMM_SIMPLE
#define GEMM_SIMPLE 0
#endif
#ifndef DBG_SAFE
#define DBG_SAFE 0
#endif
#ifndef DBG_PH_HI
#define DBG_PH_HI 20
#endif
#ifndef MK_PER_PHASE
#define MK_PER_PHASE 0
#endif

#define GAS __attribute__((address_space(1)))
#define LAS __attribute__((address_space(3)))
#define DI __device__ __forceinline__
typedef unsigned short bf16;
typedef unsigned v4u __attribute__((ext_vector_type(4)));
typedef unsigned v2u __attribute__((ext_vector_type(2)));
typedef float f32x4 __attribute__((ext_vector_type(4)));
typedef float f32x2 __attribute__((ext_vector_type(2)));
typedef short bf16x8 __attribute__((ext_vector_type(8)));

constexpr int D = 2048, NB = 8, SEQ = 4096, CTX = 256, DEPTH = 2;
constexpr int TL = NB * SEQ, TC = NB * CTX, MT = TL + TC;
constexpr int BRW = 512, INC = 3328, NGATE = 4 * D, N2 = INC + NGATE;
constexpr int NE = 16, DE = 1024, ECAP = MT;
constexpr int MAXTILES = 288;
constexpr float EPS = 1e-6f;
constexpr int U_RX = 0, U_K = 512, U_V = 640, U_AU = 768, U_AG = 1280, U_RG = 1792, U_Q = 2304, U_P = 2816;
constexpr int B_A = 0, B_B = 512, B_C = 1024, B_D = 1536;
constexpr int MO_SH1 = 0, MO_SC1 = 2048, MO_G1 = 4096, MO_SH2 = 6144, MO_SC2 = 8192, MO_G2 = 10240, MODW = 12288;

constexpr size_t MiB = 1u << 20;
constexpr size_t WS_CTL = 0, CTL_BYTES = 1 * MiB;
constexpr size_t WS_MOD = 1 * MiB;
constexpr size_t WS_LIST = 2 * MiB;
constexpr size_t LIST_ROW = 0, LIST_W = (size_t)NE * ECAP * 4, LIST_TS = 2 * (size_t)NE * ECAP * 4, LIST_CT = LIST_TS + (size_t)MT * 2 * 4;
constexpr size_t WS_SMALLW = 7 * MiB;
constexpr size_t SW_LRU = 0, SW_POOL = 262144;
constexpr size_t WS_W2 = 8 * MiB;
constexpr size_t WS_WB = 53 * MiB;
constexpr size_t WS_WO = 61 * MiB;
constexpr size_t WS_WGU = 69 * MiB;
constexpr size_t WS_WD = 197 * MiB;
constexpr size_t WS_H = 261 * MiB;
constexpr size_t WS_U = 397 * MiB;
constexpr size_t WS_G = 618 * MiB;
constexpr size_t WS_HB = WS_G, WS_O = WS_G + 144 * MiB;
constexpr size_t WS_BR = 1050 * MiB;
constexpr size_t WS_XB = 1186 * MiB;
constexpr size_t WS_H8 = 1322 * MiB;
constexpr size_t WS_END = 1390 * MiB;
constexpr size_t W2G_OFF = (size_t)INC * D * 2;
constexpr int CW_TMO = 0;
constexpr int CW_BAR = 4096;
constexpr int CW_CNT = 16384;
constexpr int CW_QUEUE = 20480;

constexpr int RING_BYTES = 131072;
constexpr int LDSCTL_OFF = RING_BYTES;
constexpr int LDS_BYTES = 163840;
constexpr int LDS_MODV = 147456;

DI float bf2f(unsigned b) { return __uint_as_float(b << 16); }
DI float bflo(unsigned w) { return __uint_as_float(w << 16); }
DI float bfhi(unsigned w) { return __uint_as_float(w & 0xffff0000u); }
DI unsigned f2bf(float f) { unsigned u = __float_as_uint(f); return (u + 0x7fffu + ((u >> 16) & 1u)) >> 16; }
DI unsigned pk2(float lo, float hi) { return f2bf(lo) | (f2bf(hi) << 16); }
typedef __bf16 bf16x2_t __attribute__((ext_vector_type(2)));
DI unsigned cvt_pk_bf16(float lo, float hi) { const f32x2 v = {lo, hi}; const bf16x2_t b = __builtin_convertvector(v, bf16x2_t); return __builtin_bit_cast(unsigned, b); }
DI int lane_id_asm() { int l; asm volatile("v_mbcnt_lo_u32_b32 %0, -1, 0\n\tv_mbcnt_hi_u32_b32 %0, -1, %0" : "=v"(l)); return l; }
template <int M> DI float sx(float v) {
    if constexpr (M < 32) return __builtin_bit_cast(float, __builtin_amdgcn_ds_swizzle(__builtin_bit_cast(int, v), 0x1f | (M << 10)));
    else { const int idx = (lane_id_asm() ^ 32) << 2; return __builtin_bit_cast(float, __builtin_amdgcn_ds_bpermute(idx, __builtin_bit_cast(int, v))); }
}
typedef int v8i __attribute__((ext_vector_type(8)));
typedef int v4i __attribute__((ext_vector_type(4)));
DI float clamp448(float v) { return __builtin_amdgcn_fmed3f(v, -448.0f, 448.0f); }
DI unsigned fp8x4(float a, float b, float c, float d) { int r = __float_as_int(a);
    r = __builtin_amdgcn_cvt_pk_fp8_f32(clamp448(a), clamp448(b), r, false); r = __builtin_amdgcn_cvt_pk_fp8_f32(clamp448(c), clamp448(d), r, true); return (unsigned)r; }
constexpr float S_ACT = 16.0f, S_W = 512.0f, S_HB = 8.0f;
constexpr float SC_GU = 1.0f / (S_ACT * S_W), SC_DN = 1.0f / (S_HB * S_W);
DI float wave_sum(float v) { v += sx<1>(v); v += sx<2>(v); v += sx<4>(v); v += sx<8>(v); v += sx<16>(v); v += sx<32>(v); return v; }
DI float wave_max(float v) { v = fmaxf(v, sx<1>(v)); v = fmaxf(v, sx<2>(v)); v = fmaxf(v, sx<4>(v)); v = fmaxf(v, sx<8>(v)); v = fmaxf(v, sx<16>(v)); v = fmaxf(v, sx<32>(v)); return v; }
DI float sigmoidf_(float x) { return 1.0f / (1.0f + __expf(-x)); }
DI float siluf_(float x) { return x / (1.0f + __expf(-x)); }
DI float gelu_tanh(float x) { const float u = 0.7978845608028654f * (x + 0.044715f * x * x * x); const float e = __expf(2.0f * u); const float t = 1.0f - 2.0f * __builtin_amdgcn_rcpf(e + 1.0f); return 0.5f * x * (1.0f + t); }
#define LDS_WAIT() asm volatile("s_waitcnt lgkmcnt(0)" ::: "memory")
#define VM_WAIT() asm volatile("s_waitcnt vmcnt(0)" ::: "memory")
#define LBAR() do { asm volatile("s_waitcnt lgkmcnt(0)" ::: "memory"); __builtin_amdgcn_s_barrier(); asm volatile("" ::: "memory"); } while (0)

#define XB_TMO      128
#define XB_XCNT(j)  (256  + 64 * (j))
#define XB_XSUB(j)  (1280 + 64 * (j))
#define XB_XGEN(j)  (2304 + 64 * (j))
#define XB_TOP      3328
#define XB_TOPGEN   3392
#define XCD_BAR_WORDS 3456
#define XB_SPIN_CAP (1u << 20)
DI unsigned xb_ld(unsigned* p)              { return __hip_atomic_load(p, __ATOMIC_RELAXED, __HIP_MEMORY_SCOPE_AGENT); }
DI unsigned xb_add(unsigned* p, unsigned v) { return __hip_atomic_fetch_add(p, v, __ATOMIC_RELAXED, __HIP_MEMORY_SCOPE_AGENT); }
DI unsigned xb_xcc_id() { return (unsigned)__builtin_amdgcn_s_getreg((3 << 11) | 20) & 0xFu; }
#define XB_SPIN(cond, bar) do { unsigned _sp = 0; while (cond) { __builtin_amdgcn_s_sleep(1); \
    if ((++_sp & 255u) == 0u) { if (xb_ld(&(bar)[XB_TMO])) break; if (_sp > XB_SPIN_CAP) { atomicAdd(&(bar)[XB_TMO], 1u); break; } } } } while (0)
struct XcdBarrier { unsigned* bar; unsigned x; volatile LAS unsigned* st; };
DI XcdBarrier xcd_barrier_post(unsigned* bar, volatile LAS unsigned* st) {
    XcdBarrier b; b.bar = bar; b.x = xb_xcc_id(); b.st = st;
    if (threadIdx.x == 0) (void)xb_add(&bar[XB_XCNT(b.x)], 1u);
    return b;
}
DI void xcd_barrier_complete(unsigned* bar, unsigned x, unsigned& nloc, unsigned& nx) {
    const unsigned G = gridDim.x * gridDim.y * gridDim.z;
    unsigned sum, cnt, mine, sp = 0u;
    for (;;) {
        sum = 0u; cnt = 0u; mine = 0u;
#pragma unroll
        for (unsigned j = 0; j < 16; ++j) { const unsigned c = xb_ld(&bar[XB_XCNT(j)]); sum += c; cnt += (c > 0u) ? 1u : 0u; mine = (j == x) ? c : mine; }
        if (sum == G) break;
        __builtin_amdgcn_s_sleep(1);
        if ((++sp & 255u) == 0u) { if (xb_ld(&bar[XB_TMO])) break; if (sp > XB_SPIN_CAP) { atomicAdd(&bar[XB_TMO], 1u); break; } }
    }
    nloc = mine > 0u ? mine : 1u; nx = cnt > 0u ? cnt : 1u;
}
DI void xcd_barrier(const XcdBarrier& b) {
    asm volatile("s_waitcnt vmcnt(0)" ::: "memory");
    __syncthreads();
    if (threadIdx.x == 0) {
        unsigned* bar = b.bar;
        __builtin_amdgcn_s_waitcnt(0);
        unsigned nloc = b.st[0], nx = b.st[1];
        if (nloc == 0u) { xcd_barrier_complete(bar, b.x, nloc, nx); b.st[0] = nloc; b.st[1] = nx; }
        const unsigned old = xb_add(&bar[XB_XSUB(b.x)], 1u);
        const unsigned gen = old / nloc;
        if (old + 1u == (gen + 1u) * nloc) {
            __builtin_amdgcn_fence(__ATOMIC_RELEASE, "agent");
            asm volatile("s_waitcnt vmcnt(0)" ::: "memory");
            const unsigned og = xb_add(&bar[XB_TOP], 1u);
            const unsigned tg = og / nx;
            if (og + 1u == (tg + 1u) * nx) xb_add(&bar[XB_TOPGEN], 1u);
            else XB_SPIN(xb_ld(&bar[XB_TOPGEN]) == tg, bar);
            __builtin_amdgcn_fence(__ATOMIC_ACQUIRE, "agent");
            xb_add(&bar[XB_XGEN(b.x)], 1u);
            asm volatile("s_waitcnt vmcnt(0)" ::: "memory");
        } else {
            XB_SPIN(xb_ld(&bar[XB_XGEN(b.x)]) == gen, bar);
            __builtin_amdgcn_fence(__ATOMIC_ACQUIRE, "agent");
            asm volatile("s_waitcnt vmcnt(0)" ::: "memory");
        }
    }
    __syncthreads();
}

namespace pg8 {
constexpr int BM = 256, BK = 64, HALF = 128, HTB = HALF * BK * 2, STAGE_BYTES = 8 * HTB, NXCD = 8, WGM = 8;
__host__ __device__ __forceinline__ int lds_byte(int r, int c) { const int st = (r >> 4) * 2 + (c >> 5), rr = r & 15, cc = c & 31, ob = rr * 64 + cc * 2; return st * 1024 + (ob ^ (((ob >> 9) & 1) << 5)); }
__host__ __device__ __forceinline__ void stage_rc(int b, int& R, int& C) { const int st = b / 1024, sb = b % 1024, swz = sb ^ (((sb >> 9) & 1) << 5); R = (st >> 1) * 16 + swz / 64; C = (st & 1) * 32 + (swz % 64) / 2; }
__host__ __device__ __forceinline__ int perm32(int rho) { const int n = rho >> 4, i = rho & 15; return 8 * (i >> 2) + 4 * n + (i & 3); }

struct Unit {
    const char* a;
    const char* b;
    const int* rows;
    int nvalid;
    int i0, i1, i2, i3;
};
DI void tile_of(int L, int nM, int nN, int& pm, int& pn) {
    const int nwg = nM * nN; int wgid = L;
    { const int q = nwg / NXCD, r = nwg % NXCD, xcd = wgid % NXCD, off = wgid / NXCD; wgid = (xcd < r ? xcd * (q + 1) : r * (q + 1) + (xcd - r) * q) + off; }
    const int nig = WGM * nN, gid = wgid / nig, fm = gid * WGM, gsz = (nM - fm) < WGM ? (nM - fm) : WGM;
    pm = fm + ((wgid % nig) % gsz); pn = (wgid % nig) / gsz;
}

template <class Epi, class Sched, bool GATHER, bool F8 = false>
DI void gemm_phase(LAS unsigned char* lds, const int wid, const int K, const unsigned lda, const unsigned ldb, const Sched& S, const Epi& E) {
    const int lane = lane_id_asm(), tid = wid * 64 + lane; const int wr = wid >> 2, wc = wid & 3, fr = lane & 15, fq = lane >> 4;
    const int nt = K / BK;
    unsigned voffA[2], voffB[2]; int RA[2], CA2[2];
#pragma unroll
    for (int i = 0; i < 2; ++i) { int R, C; stage_rc(tid * 16 + i * 8192, R, C); const int Rb = Epi::PERM ? ((R & ~31) + perm32(R & 31)) : R;
        RA[i] = R; CA2[i] = C * 2; voffA[i] = (unsigned)R * lda + (unsigned)C * 2u; voffB[i] = (unsigned)Rb * ldb + (unsigned)C * 2u; }
    const size_t kstep = (size_t)(BK * 2);
    const size_t hstepA = GATHER ? 0 : (size_t)HALF * lda, hstepB = (size_t)HALF * ldb;
    const unsigned ldsw = (unsigned)wid * 1024u;
    const int aoff = lds_byte(wr * 64 + fr, fq * 8), boff = lds_byte(wc * 32 + fr, fq * 8);
#define PG8_SA(b, h) (((b) * 2 + (h)) * HTB)
#define PG8_SB(b, h) ((4 + (b) * 2 + (h)) * HTB)
#define PG8_GL(bufoff, gptr, o0, o1, ko) do { \
        __builtin_amdgcn_global_load_lds((const unsigned*)((const char*)(gptr) + (unsigned)((o0) + (ko))), (LAS unsigned*)(lds + (bufoff) + ldsw), 16, 0, 0); \
        __builtin_amdgcn_global_load_lds((const unsigned*)((const char*)(gptr) + (unsigned)((o1) + (ko))), (LAS unsigned*)(lds + (bufoff) + ldsw + 8192), 16, 0, 0); } while (0)
#define PG8_STB(bufoff, gptr, ko) PG8_GL(bufoff, gptr, voffB[0], voffB[1], ko)
#define PG8_STA(bufoff, gptr, h, nx, ko) do { if constexpr (GATHER) { const unsigned _o0 = (nx) ? gn[h][0] : gc[h][0], _o1 = (nx) ? gn[h][1] : gc[h][1]; PG8_GL(bufoff, gptr, _o0, _o1, ko); } \
        else { PG8_GL(bufoff, (gptr) + (h) * hstepA, voffA[0], voffA[1], ko); } } while (0)
#define PG8_CAT(p) __builtin_shufflevector(*(const LAS v4i*)(p), *(const LAS v4i*)((p) + 1024), 0, 1, 2, 3, 4, 5, 6, 7)
#define PG8_LDA(dst, b, h) do { _Pragma("unroll") for (int m = 0; m < 4; ++m) dst[m] = PG8_CAT(lds + PG8_SA(b, h) + aoff + m * 2048); } while (0)
#define PG8_LDB(dst, b, h) do { _Pragma("unroll") for (int n = 0; n < 2; ++n) dst[n] = PG8_CAT(lds + PG8_SB(b, h) + boff + n * 2048); } while (0)
#define PG8_LO(x) __builtin_bit_cast(bf16x8, __builtin_shufflevector(x, x, 0, 1, 2, 3))
#define PG8_HI(x) __builtin_bit_cast(bf16x8, __builtin_shufflevector(x, x, 4, 5, 6, 7))
#define PG8_MMA(ai, bj, At, Bt) do { __builtin_amdgcn_s_setprio(1); _Pragma("unroll") for (int m = 0; m < 4; ++m) _Pragma("unroll") for (int n = 0; n < 2; ++n) { \
        if constexpr (F8) acc[ai][bj][m][n] = __builtin_amdgcn_mfma_scale_f32_16x16x128_f8f6f4(Bt[n], At[m], acc[ai][bj][m][n], 0, 0, 0, 0, 0, 0); \
        else { acc[ai][bj][m][n] = __builtin_amdgcn_mfma_f32_16x16x32_bf16(PG8_LO(Bt[n]), PG8_LO(At[m]), acc[ai][bj][m][n], 0, 0, 0); \
               acc[ai][bj][m][n] = __builtin_amdgcn_mfma_f32_16x16x32_bf16(PG8_HI(Bt[n]), PG8_HI(At[m]), acc[ai][bj][m][n], 0, 0, 0); } } \
        __builtin_amdgcn_s_setprio(0); } while (0)
#if DBG_SAFE
#define PG8_WAIT_V(n) asm volatile("s_waitcnt vmcnt(0)" ::: "memory")
#else
#define PG8_WAIT_V(n) asm volatile("s_waitcnt vmcnt(" #n ")" ::: "memory")
#endif
#define PG8_WAIT_L(n) asm volatile("s_waitcnt lgkmcnt(" #n ")" ::: "memory")
#define PG8_BAR __builtin_amdgcn_s_barrier()
#define PG8_SCHED __builtin_amdgcn_sched_barrier(0)
    Unit cur, nxt; int ui = 0;
    if (!S.next(0, cur)) return;
    unsigned gc[2][2], gn[2][2];
    if constexpr (GATHER) {
#pragma unroll
        for (int h = 0; h < 2; ++h)
#pragma unroll
            for (int i = 0; i < 2; ++i) { const int rr = h * HALF + RA[i]; const int idx = rr < cur.nvalid ? *(const int*)((const char*)cur.rows + (unsigned)rr * 4u) : 0; gc[h][i] = (unsigned)idx * lda + (unsigned)CA2[i]; gn[h][i] = gc[h][i]; }
    }
    f32x4 acc[2][2][4][2];
#pragma unroll
    for (int a = 0; a < 2; ++a)
#pragma unroll
        for (int b = 0; b < 2; ++b)
#pragma unroll
            for (int m = 0; m < 4; ++m)
#pragma unroll
                for (int n = 0; n < 2; ++n) acc[a][b][m][n] = (f32x4){0.f, 0.f, 0.f, 0.f};
    const char* cA = cur.a; const char* cB = cur.b;
    PG8_STB(PG8_SB(0, 0), cB, 0u); PG8_STB(PG8_SB(0, 1), cB + hstepB, 0u); PG8_STA(PG8_SA(0, 0), cA, 0, false, 0u); PG8_STA(PG8_SA(0, 1), cA, 1, false, 0u);
    if (wr == 1) PG8_BAR;
    PG8_WAIT_V(2); PG8_BAR;
    PG8_STB(PG8_SB(1, 0), cB, 128u); PG8_STA(PG8_SA(1, 0), cA, 0, false, 128u); PG8_STB(PG8_SB(1, 1), cB + hstepB, 128u);
    PG8_WAIT_V(6); PG8_BAR;
    for (;;) {
        const bool has_next = S.next(ui + 1, nxt);
        const char* nA = has_next ? nxt.a : cA; const char* nB = has_next ? nxt.b : cB;
        if constexpr (GATHER) {
            if (has_next) {
                const int tid2 = wid * 64 + lane_id_asm();
#pragma unroll
                for (int i = 0; i < 2; ++i) { int R, C; stage_rc(tid2 * 16 + i * 8192, R, C);
#pragma unroll
                    for (int h = 0; h < 2; ++h) { const int rr = h * HALF + R; const int idx = rr < nxt.nvalid ? *(const int*)((const char*)nxt.rows + (unsigned)rr * 4u) : 0; gn[h][i] = (unsigned)idx * lda + (unsigned)C * 2u; } }
            } else {
#pragma unroll
                for (int h = 0; h < 2; ++h)
#pragma unroll
                    for (int i = 0; i < 2; ++i) gn[h][i] = gc[h][i];
            }
        }
#pragma unroll 1
        for (int t = 0; t < nt; t += 2) {
            const bool last = (t == nt - 2);
            v8i At[4], B0[2], B1[2];
            const unsigned k1 = (unsigned)(t + 1) * 128u, k2 = last ? 0u : (unsigned)(t + 2) * 128u, k3 = k2 + 128u;
            const char* a2 = last ? nA : cA; const char* b2 = last ? nB : cB;
            PG8_LDB(B0, 0, 0); PG8_LDB(B1, 0, 1); PG8_SCHED; PG8_LDA(At, 0, 0); PG8_STA(PG8_SA(1, 1), cA, 1, false, k1);
            PG8_WAIT_V(8); PG8_WAIT_L(0); PG8_BAR; PG8_MMA(0, 0, At, B0); PG8_MMA(0, 1, At, B1); PG8_BAR; PG8_SCHED;
            PG8_LDA(At, 0, 1); PG8_STB(PG8_SB(0, 0), b2, k2); PG8_STB(PG8_SB(0, 1), b2 + hstepB, k2); PG8_STA(PG8_SA(0, 0), a2, 0, last, k2);
            PG8_WAIT_V(8); PG8_WAIT_L(0); PG8_BAR; PG8_MMA(1, 0, At, B0); PG8_MMA(1, 1, At, B1); PG8_BAR; PG8_SCHED;
            PG8_LDB(B0, 1, 0); PG8_LDB(B1, 1, 1); PG8_SCHED; PG8_LDA(At, 1, 0); PG8_STA(PG8_SA(0, 1), a2, 1, last, k2);
            PG8_WAIT_V(8); PG8_WAIT_L(0); PG8_BAR; PG8_MMA(0, 0, At, B0); PG8_MMA(0, 1, At, B1); PG8_BAR; PG8_SCHED;
            PG8_LDA(At, 1, 1); PG8_STB(PG8_SB(1, 0), b2, k3); PG8_STB(PG8_SB(1, 1), b2 + hstepB, k3); PG8_STA(PG8_SA(1, 0), a2, 0, last, k3);
            PG8_WAIT_V(8); PG8_WAIT_L(0); PG8_BAR; PG8_MMA(1, 0, At, B0); PG8_MMA(1, 1, At, B1); PG8_BAR; PG8_SCHED;
        }
        if (wr == 0) PG8_BAR;
        const int ln_ = lane_id_asm(), fr_ = ln_ & 15, fq_ = ln_ >> 4;
        const bool keep = E(acc, cur, wr, wc, fr_, fq_);
        if (!has_next) break;
        if (!keep) {
#pragma unroll
            for (int a = 0; a < 2; ++a)
#pragma unroll
                for (int b = 0; b < 2; ++b)
#pragma unroll
                    for (int m = 0; m < 4; ++m)
#pragma unroll
                        for (int n = 0; n < 2; ++n) acc[a][b][m][n] = (f32x4){0.f, 0.f, 0.f, 0.f};
        }
        cur = nxt; cA = nA; cB = nB; ++ui;
        if constexpr (GATHER) {
#pragma unroll
            for (int h = 0; h < 2; ++h)
#pragma unroll
                for (int i = 0; i < 2; ++i) gc[h][i] = gn[h][i];
        }
        if (wr == 1) PG8_BAR;
    }
    PG8_WAIT_V(0);
    PG8_BAR;
#undef PG8_SA
#undef PG8_SB
#undef PG8_GL
#undef PG8_STB
#undef PG8_STA
#undef PG8_CAT
#undef PG8_LO
#undef PG8_HI
#undef PG8_LDA
#undef PG8_LDB
#undef PG8_MMA
#undef PG8_WAIT_V
#undef PG8_WAIT_L
#undef PG8_BAR
#undef PG8_SCHED
}

template <class Epi, class Sched, bool GATHER>
DI void gemm_phase_simple(LAS unsigned char* lds, const int wid, const int K, const unsigned lda, const unsigned ldb, const Sched& S, const Epi& E) {
    const int lane = lane_id_asm(), tid = wid * 64 + lane; const int wr = wid >> 2, wc = wid & 3, fr = lane & 15, fq = lane >> 4;
    const int nt = K / BK;
    unsigned voffA[2], voffB[2]; int RA[2], CA2[2];
#pragma unroll
    for (int i = 0; i < 2; ++i) { int R, C; stage_rc(tid * 16 + i * 8192, R, C); const int Rb = Epi::PERM ? ((R & ~31) + perm32(R & 31)) : R;
        RA[i] = R; CA2[i] = C * 2; voffA[i] = (unsigned)R * lda + (unsigned)C * 2u; voffB[i] = (unsigned)Rb * ldb + (unsigned)C * 2u; }
    const size_t hstepA = (size_t)HALF * lda, hstepB = (size_t)HALF * ldb;
    const int aoff = lds_byte(wr * 64 + fr, fq * 8), boff = lds_byte(wc * 32 + fr, fq * 8);
    Unit cur;
    f32x4 acc[2][2][4][2];
#pragma unroll
        for (int a = 0; a < 2; ++a)
#pragma unroll
            for (int b = 0; b < 2; ++b)
#pragma unroll
                for (int m = 0; m < 4; ++m)
#pragma unroll
                    for (int n = 0; n < 2; ++n) acc[a][b][m][n] = (f32x4){0.f, 0.f, 0.f, 0.f};
    for (int ui = 0; S.next(ui, cur); ++ui) {
        unsigned ga[2][2];
#pragma unroll
        for (int h = 0; h < 2; ++h)
#pragma unroll
            for (int i = 0; i < 2; ++i) {
                if constexpr (GATHER) { const int rr = h * HALF + RA[i]; const int idx = rr < cur.nvalid ? *(const int*)((const char*)cur.rows + (unsigned)rr * 4u) : 0; ga[h][i] = (unsigned)idx * lda + (unsigned)CA2[i]; }
                else ga[h][i] = (unsigned)(h * hstepA) + voffA[i];
            }
        for (int t = 0; t < nt; ++t) {
            v4u ra[2][2], rb[2][2];
#pragma unroll
            for (int h = 0; h < 2; ++h)
#pragma unroll
                for (int i = 0; i < 2; ++i) { ra[h][i] = *(const v4u*)(cur.a + (size_t)t * 128 + ga[h][i]); rb[h][i] = *(const v4u*)(cur.b + (size_t)t * 128 + h * hstepB + voffB[i]); }
            __syncthreads();
#pragma unroll
            for (int h = 0; h < 2; ++h)
#pragma unroll
                for (int i = 0; i < 2; ++i) { *(LAS v4u*)(lds + h * HTB + tid * 16 + i * 8192) = ra[h][i]; *(LAS v4u*)(lds + (4 + h) * HTB + tid * 16 + i * 8192) = rb[h][i]; }
            __syncthreads();
#pragma unroll
            for (int ai = 0; ai < 2; ++ai) {
                bf16x8 At[4][2];
#pragma unroll
                for (int m = 0; m < 4; ++m)
#pragma unroll
                    for (int k = 0; k < 2; ++k) At[m][k] = *(const LAS bf16x8*)(lds + ai * HTB + aoff + m * 2048 + k * 1024);
#pragma unroll
                for (int bj = 0; bj < 2; ++bj) {
                    bf16x8 Bt[2][2];
#pragma unroll
                    for (int n = 0; n < 2; ++n)
#pragma unroll
                        for (int k = 0; k < 2; ++k) Bt[n][k] = *(const LAS bf16x8*)(lds + (4 + bj) * HTB + boff + n * 2048 + k * 1024);
#pragma unroll
                    for (int m = 0; m < 4; ++m)
#pragma unroll
                        for (int n = 0; n < 2; ++n)
#pragma unroll
                            for (int k = 0; k < 2; ++k) acc[ai][bj][m][n] = __builtin_amdgcn_mfma_f32_16x16x32_bf16(Bt[n][k], At[m][k], acc[ai][bj][m][n], 0, 0, 0);
                }
            }
        }
        asm volatile("s_nop 15\n\ts_nop 15" ::: "memory");
        const bool keep = E(acc, cur, wr, wc, fr, fq);
        if (!keep) {
#pragma unroll
            for (int a = 0; a < 2; ++a)
#pragma unroll
                for (int b = 0; b < 2; ++b)
#pragma unroll
                    for (int m = 0; m < 4; ++m)
#pragma unroll
                        for (int n = 0; n < 2; ++n) acc[a][b][m][n] = (f32x4){0.f, 0.f, 0.f, 0.f};
        }
    }
    __syncthreads();
}
}
using pg8::Unit;
#if GEMM_SIMPLE
#define GEMM_PHASE gemm_phase_simple
#else
#define GEMM_PHASE gemm_phase
#endif

struct Params {
    const float* in[34];
    float* out; unsigned char* ws;
    int ph_lo, ph_hi;
};
enum { I_X = 0, I_C, I_CTX, I_CCTX, I_WADA, I_BADA, I_NMG, I_NFG, I_WIN, I_CONVW, I_CONVB, I_CLNG, I_CLNB, I_LCW, I_LCB, I_LWA, I_LBA, I_LWX, I_LBX, I_LLAM,
       I_QNG, I_KNG, I_SINK, I_POOLW, I_POOLS, I_WBR, I_WGATE, I_BGATE, I_WOUT, I_WROUTER, I_RBIAS, I_EWG, I_EWU, I_EWD };
struct Frame {
    LAS unsigned char* lds;
    unsigned* ctl;
    int tid, lane, wave, G, bid;
    const __attribute__((address_space(4))) Params* p;
    unsigned char* ws;
};
#define WSP(T, off) ((T*)(F.ws + (off)))

DI void mod_gemv(Frame& F) {
    if (F.bid >= 192) return;
    const int l = F.bid / 96, col0 = (F.bid % 96) * 128;
    LAS float* sc9 = (LAS float*)F.lds;
    LAS float* red = (LAS float*)(F.lds + 73728);
    const float* c = F.p->in[I_C]; const float* cc = F.p->in[I_CCTX];
    for (int i = F.tid; i < 9 * D; i += 512) { const int r = i / D, k = i % D; const float v = (r < 8) ? c[r * D + k] : cc[k]; sc9[i] = siluf_(v); }
    __syncthreads();
    float acc[9][2];
#pragma unroll
    for (int r = 0; r < 9; ++r) { acc[r][0] = 0.f; acc[r][1] = 0.f; }
    const int k0 = F.wave * 256;
    const float2* wp = (const float2*)(F.p->in[I_WADA] + (size_t)l * D * MODW + (size_t)k0 * MODW + col0 + 2 * F.lane);
#pragma unroll 8
    for (int kk = 0; kk < 256; ++kk) {
        const float2 wv = wp[(size_t)kk * (MODW / 2)];
#pragma unroll
        for (int r = 0; r < 9; ++r) { const float s = sc9[r * D + k0 + kk]; acc[r][0] += s * wv.x; acc[r][1] += s * wv.y; }
    }
#pragma unroll
    for (int r = 0; r < 9; ++r) { red[(F.wave * 9 + r) * 128 + 2 * F.lane] = acc[r][0]; red[(F.wave * 9 + r) * 128 + 2 * F.lane + 1] = acc[r][1]; }
    __syncthreads();
    float* mod = WSP(float, WS_MOD);
    const float* bada = F.p->in[I_BADA];
    for (int i = F.tid; i < 9 * 128; i += 512) { const int r = i / 128, n = i % 128; float s = 0.f;
#pragma unroll
        for (int w = 0; w < 8; ++w) s += red[(w * 9 + r) * 128 + n];
        mod[(size_t)(l * 9 + r) * MODW + col0 + n] = s + bada[l * MODW + col0 + n]; }
    __syncthreads();
}

DI void cvt_item(const float* W, int Nsrc, int k0, int n0, bf16* WT, size_t drow0, int Kd, LAS float* scr, int lane) {
#pragma unroll 8
    for (int i = 0; i < 32; ++i) { const int kk = 2 * i + (lane >> 5); scr[kk * 33 + (lane & 31)] = W[(size_t)(k0 + kk) * Nsrc + n0 + (lane & 31)]; }
    LDS_WAIT(); asm volatile("" ::: "memory");
    const int c = lane & 7;
#pragma unroll
    for (int j = 0; j < 4; ++j) { const int n = (lane >> 3) + 8 * j; const LAS float* s = scr + (8 * c) * 33 + n;
        v4u o; o.x = pk2(s[0 * 33], s[1 * 33]); o.y = pk2(s[2 * 33], s[3 * 33]); o.z = pk2(s[4 * 33], s[5 * 33]); o.w = pk2(s[6 * 33], s[7 * 33]);
        *(v4u*)(WT + (drow0 + n) * (size_t)Kd + k0 + 8 * c) = o; }
    LDS_WAIT(); asm volatile("" ::: "memory");
}
DI void cvt_item8(const float* W, int Nsrc, int k0, int n0, unsigned char* WT, size_t drow0, int Kd, float scale, LAS float* scr, int lane) {
#pragma unroll 8
    for (int i = 0; i < 32; ++i) { const int kk = 2 * i + (lane >> 5); scr[kk * 33 + (lane & 31)] = W[(size_t)(k0 + kk) * Nsrc + n0 + (lane & 31)]; }
    LDS_WAIT(); asm volatile("" ::: "memory");
    const int c = lane & 7;
#pragma unroll
    for (int j = 0; j < 4; ++j) { const int n = (lane >> 3) + 8 * j; const LAS float* s = scr + (8 * c) * 33 + n;
        v2u o; o.x = fp8x4(s[0 * 33] * scale, s[1 * 33] * scale, s[2 * 33] * scale, s[3 * 33] * scale); o.y = fp8x4(s[4 * 33] * scale, s[5 * 33] * scale, s[6 * 33] * scale, s[7 * 33] * scale);
        *(v2u*)(WT + (drow0 + n) * (size_t)Kd + k0 + 8 * c) = o; }
    LDS_WAIT(); asm volatile("" ::: "memory");
}
DI int win_dst(int n) {
    if (n < 512) return U_AU + n; if (n < 1024) return U_AG + (n - 512); if (n < 1536) return U_RX + (n - 1024); if (n < 2048) return U_RG + (n - 1536);
    if (n < 2560) return U_Q + (n - 2048); if (n < 2688) return U_K + (n - 2560); if (n < 2816) return U_V + (n - 2688); return U_P + (n - 2816);
}
DI void convert_weights(Frame& F, int l) {
    LAS float* scr = (LAS float*)(F.lds + F.wave * 16384);
    constexpr int I1 = 32 * 104, I2 = 4 * 32 * 64, I3 = 4 * 8 * 64, I4 = 32 * 64, I5 = 16 * 32 * 32, I6 = I5, I7 = 16 * 16 * 64, I8 = 16 * 2, I9 = 16 * 2, I10 = 4 * 2 * 4;
    constexpr int NIT = I1 + I2 + I3 + I4 + I5 + I6 + I7 + I8 + I9 + I10;
    bf16* W2 = WSP(bf16, WS_W2); bf16* WB = WSP(bf16, WS_WB); bf16* WO = WSP(bf16, WS_WO); bf16* WGU = WSP(bf16, WS_WGU); bf16* WD = WSP(bf16, WS_WD);
    bf16* WL = WSP(bf16, WS_SMALLW + SW_LRU); bf16* WP = WSP(bf16, WS_SMALLW + SW_POOL);
    const int gw = F.bid * 8 + F.wave, NGW = F.G * 8;
    for (int it = gw; it < NIT; it += NGW) {
        int r = it;
        if (r < I1) { const int kb = r / 104, nb = r % 104;
#if F8_WIN
            cvt_item8(F.p->in[I_WIN] + (size_t)l * D * INC, INC, kb * 64, nb * 32, (unsigned char*)W2, (size_t)win_dst(nb * 32), D, S_W, scr, F.lane);
#else
            cvt_item(F.p->in[I_WIN] + (size_t)l * D * INC, INC, kb * 64, nb * 32, W2, (size_t)win_dst(nb * 32), D, scr, F.lane);
#endif
            continue; } r -= I1;
        if (r < I2) { const int g = r / 2048, q = r % 2048, kb = q / 64, nb = q % 64; cvt_item8(F.p->in[I_WGATE] + ((size_t)l * 4 + g) * D * D, D, kb * 64, nb * 32, (unsigned char*)W2 + W2G_OFF, (size_t)g * D + nb * 32, D, S_W, scr, F.lane); continue; } r -= I2;
        if (r < I3) { const int g = r / 512, q = r % 512, kb = q / 64, nb = q % 64; cvt_item(F.p->in[I_WBR] + ((size_t)l * 4 + g) * BRW * D, D, kb * 64, nb * 32, WB, (size_t)g * D + nb * 32, BRW, scr, F.lane); continue; } r -= I3;
        if (r < I4) { const int kb = r / 64, nb = r % 64;
#if F8_WOUT
            cvt_item8(F.p->in[I_WOUT] + (size_t)l * D * D, D, kb * 64, nb * 32, (unsigned char*)WO, (size_t)nb * 32, D, S_W, scr, F.lane);
#else
            cvt_item(F.p->in[I_WOUT] + (size_t)l * D * D, D, kb * 64, nb * 32, WO, (size_t)nb * 32, D, scr, F.lane);
#endif
            continue; } r -= I4;
        if (r < I5) { const int e = r / 1024, q = r % 1024, kb = q / 32, nb = q % 32, n = nb * 32; cvt_item8(F.p->in[I_EWG] + ((size_t)l * NE + e) * D * DE, DE, kb * 64, n, (unsigned char*)WGU, (size_t)e * 2048 + (n / 128) * 256 + (n % 128), D, S_W, scr, F.lane); continue; } r -= I5;
        if (r < I6) { const int e = r / 1024, q = r % 1024, kb = q / 32, nb = q % 32, n = nb * 32; cvt_item8(F.p->in[I_EWU] + ((size_t)l * NE + e) * D * DE, DE, kb * 64, n, (unsigned char*)WGU, (size_t)e * 2048 + (n / 128) * 256 + 128 + (n % 128), D, S_W, scr, F.lane); continue; } r -= I6;
        if (r < I7) { const int e = r / 1024, q = r % 1024, kb = q / 64, nb = q % 64; cvt_item8(F.p->in[I_EWD] + ((size_t)l * NE + e) * DE * D, D, kb * 64, nb * 32, (unsigned char*)WD, (size_t)e * 2048 + nb * 32, DE, S_W, scr, F.lane); continue; } r -= I7;
        if (r < I8) { const int mat = r / 2, nb = r % 2;
            const int d = mat / 8, h = mat % 8; cvt_item(F.p->in[I_LWA] + (((size_t)l * 2 + d) * 8 + h) * 4096, 64, 0, nb * 32, WL, (size_t)((d * 2 + 0) * 8 + h) * 64 + nb * 32, 64, scr, F.lane); continue; } r -= I8;
        if (r < I9) { const int mat = r / 2, nb = r % 2;
            const int d = mat / 8, h = mat % 8; cvt_item(F.p->in[I_LWX] + (((size_t)l * 2 + d) * 8 + h) * 4096, 64, 0, nb * 32, WL, (size_t)((d * 2 + 1) * 8 + h) * 64 + nb * 32, 64, scr, F.lane); continue; } r -= I9;
        { const int g = r / 8, q = r % 8, kb = q / 4, nb = q % 4; cvt_item(F.p->in[I_POOLW] + ((size_t)l * 4 + g) * 16384, 128, kb * 64, nb * 32, WP, (size_t)g * 128 + nb * 32, 128, scr, F.lane); }
    }
}

constexpr int LC_SCR = LDSCTL_OFF + 256;

DI void norm_phase(Frame& F, int l, int mode) {
    const int gw = F.bid * 8 + F.wave, NGW = F.G * 8;
    LAS int* offs = (LAS int*)(F.lds + LC_SCR);
    const int lp = (mode == 1) ? l - 1 : DEPTH - 1;
    if (mode != 0) {
        if (F.tid == 0) { int acc = 0; for (int e = 0; e < NE; ++e) { const int c = (int)__hip_atomic_load(F.ctl + CW_CNT + (lp * 16 + e) * 64, __ATOMIC_RELAXED, __HIP_MEMORY_SCOPE_AGENT); offs[e] = acc * 256; acc += (c + 255) >> 8; } }
        __syncthreads();
    }
    const int nrows = (mode == 2) ? TL : MT;
    const float* mod = WSP(float, WS_MOD);
    const int* tokslot = (const int*)(F.ws + WS_LIST + LIST_TS);
    const bf16* O = WSP(bf16, WS_O);
    bf16* H = WSP(bf16, WS_H); unsigned char* H8 = WSP(unsigned char, WS_H8);
    int ns0 = 0, ns1 = 0;
    if (mode != 0 && gw < nrows) { ns0 = tokslot[gw * 2]; ns1 = tokslot[gw * 2 + 1]; }
    for (int row = gw; row < nrows; row += NGW) {
        const bool lat = row < TL; const int bidx = lat ? row / SEQ : 8;
        bf16* xb = WSP(bf16, WS_XB) + (size_t)row * D;
        f32x4 v[8];
        if (mode == 0) { const float* xs = lat ? F.p->in[I_X] + (size_t)row * D : F.p->in[I_CTX] + (size_t)(row - TL) * D;
#pragma unroll
            for (int j = 0; j < 8; ++j) v[j] = ((const f32x4*)xs)[F.lane + 64 * j];
        } else {
#pragma unroll
            for (int j = 0; j < 8; ++j) { const v2u t = *(const v2u*)(xb + 4 * F.lane + 256 * j); v[j] = (f32x4){bflo(t.x), bfhi(t.x), bflo(t.y), bfhi(t.y)}; }
        }
        if (mode != 0) {
            const int s0 = ns0, s1 = ns1;
            if (row + NGW < nrows) { ns0 = tokslot[(row + NGW) * 2]; ns1 = tokslot[(row + NGW) * 2 + 1]; }
            const size_t sl0 = (size_t)(offs[s0 >> 20] + (s0 & 0xfffff)), sl1 = (size_t)(offs[s1 >> 20] + (s1 & 0xfffff));
            const float* g2 = mod + (size_t)(lp * 9 + bidx) * MODW + MO_G2;
            v2u o0[8], o1[8]; f32x4 gv[8];
#pragma unroll
            for (int j = 0; j < 8; ++j) { o0[j] = *(const v2u*)(O + sl0 * D + 4 * F.lane + 256 * j); o1[j] = *(const v2u*)(O + sl1 * D + 4 * F.lane + 256 * j); gv[j] = ((const f32x4*)g2)[F.lane + 64 * j]; }
#pragma unroll
            for (int j = 0; j < 8; ++j) {
                v[j].x += gv[j].x * (bflo(o0[j].x) + bflo(o1[j].x)); v[j].y += gv[j].y * (bfhi(o0[j].x) + bfhi(o1[j].x));
                v[j].z += gv[j].z * (bflo(o0[j].y) + bflo(o1[j].y)); v[j].w += gv[j].w * (bfhi(o0[j].y) + bfhi(o1[j].y)); }
            if (mode == 2) { float* xd = F.p->out + (size_t)row * D;
#pragma unroll
                for (int j = 0; j < 8; ++j) ((f32x4*)xd)[F.lane + 64 * j] = v[j];
            } else {
#pragma unroll
                for (int j = 0; j < 8; ++j) { v2u t; t.x = cvt_pk_bf16(v[j].x, v[j].y); t.y = cvt_pk_bf16(v[j].z, v[j].w); *(v2u*)(xb + 4 * F.lane + 256 * j) = t; }
            }
        }
        if (mode != 2) {
            float ss = 0.f;
#pragma unroll
            for (int j = 0; j < 8; ++j) ss += (v[j].x * v[j].x + v[j].y * v[j].y) + (v[j].z * v[j].z + v[j].w * v[j].w);
            ss = wave_sum(ss);
            const float r = 1.0f / sqrtf(ss * (1.0f / D) + EPS);
            const float* gain = F.p->in[I_NMG] + l * D; const float* sh = mod + (size_t)(l * 9 + bidx) * MODW + MO_SH1; const float* sc = mod + (size_t)(l * 9 + bidx) * MODW + MO_SC1;
            f32x4 gn[8], s_[8], b_[8];
#pragma unroll
            for (int j = 0; j < 8; ++j) { gn[j] = ((const f32x4*)gain)[F.lane + 64 * j]; s_[j] = ((const f32x4*)sc)[F.lane + 64 * j]; b_[j] = ((const f32x4*)sh)[F.lane + 64 * j]; }
#pragma unroll
            for (int j = 0; j < 8; ++j) {
                const float h0 = (v[j].x * r) * gn[j].x * (1.0f + s_[j].x) + b_[j].x, h1 = (v[j].y * r) * gn[j].y * (1.0f + s_[j].y) + b_[j].y;
                const float h2 = (v[j].z * r) * gn[j].z * (1.0f + s_[j].z) + b_[j].z, h3 = (v[j].w * r) * gn[j].w * (1.0f + s_[j].w) + b_[j].w;
                v2u o; o.x = pk2(h0, h1); o.y = pk2(h2, h3);
                if (!F8_WIN) *(v2u*)(H + (size_t)row * D + 4 * F.lane + 256 * j) = o;
                *(unsigned*)(H8 + (size_t)row * D + 4 * F.lane + 256 * j) = fp8x4(h0 * S_ACT, h1 * S_ACT, h2 * S_ACT, h3 * S_ACT);
            }
        }
    }
}

#if PROBE_RT
#define RP_T0() unsigned long long rp_t_ = __builtin_amdgcn_s_memrealtime()
#define RP_END(bit) do { const unsigned long long t1_ = __builtin_amdgcn_s_memrealtime(); if (PROBE_RT & (bit)) { const unsigned long long dt_ = t1_ - rp_t_; while (__builtin_amdgcn_s_memrealtime() - t1_ < dt_) __builtin_amdgcn_s_sleep(4); } rp_t_ = __builtin_amdgcn_s_memrealtime(); } while (0)
#else
#define RP_T0() do { } while (0)
#define RP_END(bit) do { } while (0)
#endif
DI void router_phase(Frame& F, int l) {
    const int nrows = (l == 0) ? MT : TL, rpw = nrows / F.G;
    auto row_of = [&](int lr) { return (lr < 128) ? F.bid * 128 + lr : TL + F.bid * 8 + (lr - 128); };
    LAS unsigned char* frag = F.lds;
    LAS int* asg_e = (LAS int*)(F.lds + LC_SCR);
    LAS float* asg_w = (LAS float*)(F.lds + LC_SCR + 1088);
    LAS int* asg_r = (LAS int*)(F.lds + LC_SCR + 2176);
    LAS float* part = (LAS float*)(F.lds + LC_SCR + 4096);
    for (int s2 = F.tid; s2 < 272; s2 += 512) asg_e[s2] = -1;
    const float* wrt = F.p->in[I_WROUTER];
    float wb[64];
#pragma unroll
    for (int q = 0; q < 64; ++q) wb[q] = wrt[(size_t)(4 * (64 * F.wave + q) + (F.lane >> 4)) * NE + (F.lane & 15)];
    const float* mod = WSP(float, WS_MOD);
    unsigned char* H2 = WSP(unsigned char, WS_H);
    const float* gain = F.p->in[I_NFG] + l * D;
    LAS float* lm = (LAS float*)(F.lds + LDS_MODV);
    const bf16* XBp = WSP(bf16, WS_XB);
    int staged = -1;
    v2u xq[2][8];
#pragma unroll
    for (int t2 = 0; t2 < 2; ++t2) { const int lr = 2 * F.wave + t2; const int row = row_of((lr < rpw) ? lr : 0);
#pragma unroll
        for (int j = 0; j < 8; ++j) xq[t2][j] = *(const v2u*)(XBp + (size_t)row * D + 4 * F.lane + 256 * j); }
    __syncthreads();
    RP_T0();
    for (int g0 = 0; g0 < rpw; g0 += 16) {
        { const int rowg = row_of(g0), bg = (rowg < TL) ? rowg / SEQ : 8;
          if (bg != staged) {
              const float* sh = mod + (size_t)(l * 9 + bg) * MODW + MO_SH2; const float* sc = mod + (size_t)(l * 9 + bg) * MODW + MO_SC2;
              { const f32x4 g_ = ((const f32x4*)gain)[F.tid], c_ = ((const f32x4*)sc)[F.tid], h_ = ((const f32x4*)sh)[F.tid];
                ((LAS f32x4*)lm)[F.tid] = g_ * (1.0f + c_); ((LAS f32x4*)(lm + 2048))[F.tid] = h_; }
              staged = bg;
              __syncthreads();
          } }
        v2u xc[2][8];
#pragma unroll
        for (int t2 = 0; t2 < 2; ++t2)
#pragma unroll
            for (int j = 0; j < 8; ++j) xc[t2][j] = xq[t2][j];
        if (g0 + 16 < rpw) {
#pragma unroll
            for (int t2 = 0; t2 < 2; ++t2) { const int lrn = g0 + 16 + 2 * F.wave + t2; const int rown = row_of((lrn < rpw) ? lrn : 0);
#pragma unroll
                for (int j = 0; j < 8; ++j) xq[t2][j] = *(const v2u*)(XBp + (size_t)rown * D + 4 * F.lane + 256 * j); } }
#pragma unroll
        for (int t2 = 0; t2 < 2; ++t2) {
            const int tl = 2 * F.wave + t2, lr = g0 + tl; const bool valid = lr < rpw; const int row = row_of(valid ? lr : 0);
            const bool lat = row < TL; const int bidx = lat ? row / SEQ : 8;
            f32x4 v[8];
#pragma unroll
            for (int j = 0; j < 8; ++j) { const v2u t = xc[t2][j]; v[j] = (f32x4){bflo(t.x), bfhi(t.x), bflo(t.y), bfhi(t.y)}; }
            float ss = 0.f;
#pragma unroll
            for (int j = 0; j < 8; ++j) ss += (v[j].x * v[j].x + v[j].y * v[j].y) + (v[j].z * v[j].z + v[j].w * v[j].w);
            ss = wave_sum(ss);
            const float r = 1.0f / sqrtf(ss * (1.0f / D) + EPS);
#pragma unroll
            for (int jh = 0; jh < 2; ++jh) {
                f32x4 gmv[4], bv[4];
#pragma unroll
                for (int j4 = 0; j4 < 4; ++j4) { gmv[j4] = ((const LAS f32x4*)lm)[F.lane + 64 * (4 * jh + j4)]; bv[j4] = ((const LAS f32x4*)(lm + 2048))[F.lane + 64 * (4 * jh + j4)]; }
#pragma unroll
                for (int j4 = 0; j4 < 4; ++j4) { const int j = 4 * jh + j4;
                    const f32x4 gm = gmv[j4], b_ = bv[j4];
                    f32x4 hq; hq.x = (v[j].x * r) * gm.x + b_.x; hq.y = (v[j].y * r) * gm.y + b_.y; hq.z = (v[j].z * r) * gm.z + b_.z; hq.w = (v[j].w * r) * gm.w + b_.w;
                    if (valid) *(unsigned*)(H2 + (size_t)row * D + 4 * F.lane + 256 * j) = fp8x4(hq.x * S_ACT, hq.y * S_ACT, hq.z * S_ACT, hq.w * S_ACT);
                    else hq = (f32x4){0.f, 0.f, 0.f, 0.f};
                    *(LAS f32x4*)(frag + ((F.lane + 64 * j) * 16 + (tl ^ (F.lane & 15))) * 16) = hq;
                }
            }
        }
        LBAR(); RP_END(1);
        { f32x4 acc = (f32x4){0.f, 0.f, 0.f, 0.f};
          const LAS unsigned char* ap = frag + (64 * F.wave) * 256 + (F.lane >> 4) * 4; const int tsl = (F.lane & 15) * 16;
#pragma unroll
          for (int q = 0; q < 64; ++q) { int t_ = tsl; asm volatile("" : "+v"(t_));
              acc = __builtin_amdgcn_mfma_f32_16x16x4f32(*(const LAS float*)(ap + q * 256 + (t_ ^ ((q & 15) * 16))), wb[q], acc, 0, 0, 0); }
#pragma unroll
          for (int rg = 0; rg < 4; ++rg) part[(F.wave * 16 + 4 * (F.lane >> 4) + rg) * 16 + (F.lane & 15)] = acc[rg]; }
        LBAR(); RP_END(2);
        if (F.wave == 0 && F.lane < 16 && g0 + F.lane < rpw) {
            const int tl = F.lane, row = row_of(g0 + tl);
            float sel[16], sco[16];
#pragma unroll
            for (int e = 0; e < 16; ++e) { float lg = 0.f;
#pragma unroll
                for (int w = 0; w < 8; ++w) lg += part[(w * 16 + tl) * 16 + e];
                sco[e] = __builtin_amdgcn_rcpf(1.0f + __expf(-lg)); sel[e] = sco[e] + F.p->in[I_RBIAS][e]; }
            float bestv = 0.f; int best = 0;
#pragma unroll
            for (int g = 0; g < 4; ++g) {
                const float a_ = sel[4 * g], b_ = sel[4 * g + 1], c_ = sel[4 * g + 2], d_ = sel[4 * g + 3];
                const float hi1 = fmaxf(a_, b_), lo1 = fminf(a_, b_), hi2 = fmaxf(c_, d_), lo2 = fminf(c_, d_);
                const float gs = fmaxf(hi1, hi2) + fmaxf(fminf(hi1, hi2), fmaxf(lo1, lo2));
                if (g == 0 || gs > bestv) { bestv = gs; best = g; }
            }
            float cs[4], ss4[4];
#pragma unroll
            for (int k = 0; k < 4; ++k) { cs[k] = best == 0 ? sel[k] : best == 1 ? sel[4 + k] : best == 2 ? sel[8 + k] : sel[12 + k]; ss4[k] = best == 0 ? sco[k] : best == 1 ? sco[4 + k] : best == 2 ? sco[8 + k] : sco[12 + k]; }
            int k1 = 0; float v1 = cs[0], s1 = ss4[0];
#pragma unroll
            for (int k = 1; k < 4; ++k) if (cs[k] > v1) { v1 = cs[k]; k1 = k; s1 = ss4[k]; }
            int k2 = -1; float v2 = 0.f, s2v = 0.f;
#pragma unroll
            for (int k = 0; k < 4; ++k) if (k != k1 && (k2 < 0 || cs[k] > v2)) { v2 = cs[k]; k2 = k; s2v = ss4[k]; }
            const int a = (g0 + tl) * 2; const float inv = 1.0f / (s1 + s2v);
            asg_e[a] = best * 4 + k1; asg_w[a] = s1 * inv; asg_r[a] = row;
            asg_e[a + 1] = best * 4 + k2; asg_w[a + 1] = s2v * inv; asg_r[a + 1] = row;
        }
        LBAR(); RP_END(4);
    }
    __syncthreads();
    if (F.tid < NE) {
        const int e = F.tid; int cn = 0;
        for (int a = 0; a < 272; ++a) cn += (asg_e[a] == e) ? 1 : 0;
        ((int*)(F.ws + WS_LIST + LIST_CT))[F.bid * NE + e] = cn;
    }
}
DI void router_assign(Frame& F, int l) {
    LAS int* asg_e = (LAS int*)(F.lds + LC_SCR); LAS float* asg_w = (LAS float*)(F.lds + LC_SCR + 1088); LAS int* asg_r = (LAS int*)(F.lds + LC_SCR + 2176);
    LAS int* tab = (LAS int*)F.lds;
    const int* gtab = (const int*)(F.ws + WS_LIST + LIST_CT);
    for (int i = F.tid; i < F.G * NE; i += 512) tab[i] = gtab[i];
    __syncthreads();
    if (F.tid < NE) {
        const int e = F.tid; int base = 0, tot = 0;
        for (int w = 0; w < F.G; ++w) { const int c = tab[w * NE + e]; tot += c; base += (w < F.bid) ? c : 0; }
        if (F.bid == F.G - 1) __hip_atomic_store(F.ctl + CW_CNT + (l * 16 + e) * 64, (unsigned)tot, __ATOMIC_RELAXED, __HIP_MEMORY_SCOPE_AGENT);
        int run = base;
        int* rowlist = (int*)(F.ws + WS_LIST + LIST_ROW); float* wlist = (float*)(F.ws + WS_LIST + LIST_W); int* tokslot = (int*)(F.ws + WS_LIST + LIST_TS);
        for (int a = 0; a < 272; ++a) if (asg_e[a] == e) { const int row = asg_r[a]; rowlist[(size_t)e * ECAP + run] = row; wlist[(size_t)e * ECAP + run] = asg_w[a]; tokslot[row * 2 + (a & 1)] = (e << 20) | run; ++run; }
    }
    __syncthreads();
}

DI void qk_unit(Frame& F, int l, int unit) {
    bf16* U = WSP(bf16, WS_U);
    const int j8 = F.lane & 7;
    float qg[8], kg[8];
#pragma unroll
    for (int e = 0; e < 8; ++e) { qg[e] = F.p->in[I_QNG][l * 64 + 8 * j8 + e]; kg[e] = F.p->in[I_KNG][l * 64 + 8 * j8 + e]; }
    const LAS float* rt = (const LAS float*)(F.lds + LDS_MODV);
    const bool isrow = (j8 & 3) < 2, lohalf = j8 < 4;
    const int lnk = F.lane & 15;
#pragma unroll 1
    for (int trip = 0; trip < 2; ++trip) {
        const int rowb = unit * 64 + F.wave * 8 + trip * 4;
        const bool doq = (rowb < TL) || (l == 0);
        v4u vq[4], vk[4];
#pragma unroll
        for (int t = 0; t < 4; ++t) { const size_t ro = (size_t)(rowb + t) * INC;
            vq[t] = (v4u){0u, 0u, 0u, 0u}; if (doq) vq[t] = *(const v4u*)(U + ro + U_Q + 8 * F.lane);
            vk[t] = *(const v4u*)(U + ro + U_K + 8 * lnk); }
#pragma unroll
        for (int t = 0; t < 4; ++t) {
            const int row = rowb + t; const bool lat = row < TL;
            float cs[8], sn[8];
            if (lat) { const int tt = row % SEQ; const int pos = isrow ? (tt / 64) : (tt % 64); const LAS float* tp = rt + pos * 16 + 8 * (j8 & 1);
                const f32x4 c0 = *(const LAS f32x4*)tp, c1 = *(const LAS f32x4*)(tp + 4), s0 = *(const LAS f32x4*)(tp + 1024), s1 = *(const LAS f32x4*)(tp + 1028);
                cs[0] = c0.x; cs[1] = c0.y; cs[2] = c0.z; cs[3] = c0.w; cs[4] = c1.x; cs[5] = c1.y; cs[6] = c1.z; cs[7] = c1.w;
                sn[0] = s0.x; sn[1] = s0.y; sn[2] = s0.z; sn[3] = s0.w; sn[4] = s1.x; sn[5] = s1.y; sn[6] = s1.z; sn[7] = s1.w; }
#pragma unroll
            for (int part = 0; part < 2; ++part) {
                if (part == 0 && !doq) continue;
                bf16* p = U + (size_t)row * INC + (part ? U_K : U_Q) + 8 * (part ? lnk : F.lane);
                const v4u v = part ? vk[t] : vq[t];
                float x[8] = {bflo(v.x), bfhi(v.x), bflo(v.y), bfhi(v.y), bflo(v.z), bfhi(v.z), bflo(v.w), bfhi(v.w)};
                float ss = 0.f;
#pragma unroll
                for (int e = 0; e < 8; ++e) ss += x[e] * x[e];
                ss += sx<1>(ss); ss += sx<2>(ss); ss += sx<4>(ss);
                const float r = __builtin_amdgcn_rsqf(ss * (1.0f / 64.0f) + EPS);
                float o[8];
#pragma unroll
                for (int e = 0; e < 8; ++e) { const float xn = (x[e] * r) * (part ? kg[e] : qg[e]); float ov = xn;
                    if (lat) { const float pr = sx<4>(xn); ov = lohalf ? (xn * cs[e] - pr * sn[e]) : (pr * sn[e] + xn * cs[e]); }
                    o[e] = ov; }
                v4u w; w.x = cvt_pk_bf16(o[0], o[1]); w.y = cvt_pk_bf16(o[2], o[3]); w.z = cvt_pk_bf16(o[4], o[5]); w.w = cvt_pk_bf16(o[6], o[7]);
                if (part == 0 || F.lane < 16) *(v4u*)p = w;
            }
        }
    }
}

#if PROBE_CV
#define CP_T0() unsigned long long cp_t_ = __builtin_amdgcn_s_memrealtime()
#define CP_END(bit) do { const unsigned long long t1_ = __builtin_amdgcn_s_memrealtime(); if (PROBE_CV & (bit)) { const unsigned long long dt_ = t1_ - cp_t_; while (__builtin_amdgcn_s_memrealtime() - t1_ < dt_) __builtin_amdgcn_s_sleep(4); } cp_t_ = __builtin_amdgcn_s_memrealtime(); } while (0)
#else
#define CP_T0() do { } while (0)
#define CP_END(bit) do { } while (0)
#endif
DI void conv_unit(Frame& F, int l, int cu) {
    const bf16* U = WSP(bf16, WS_U); bf16* BR = WSP(bf16, WS_BR);
    LAS float* Y = (LAS float*)F.lds;
    const int r0 = cu * 32;
    CP_T0();
    const int seq_lo = (r0 < TL) ? (r0 / SEQ) * SEQ : TL + ((r0 - TL) / CTX) * CTX, seq_hi = seq_lo + ((r0 < TL) ? SEQ : CTX);
    const int c = F.tid; float w[31];
    const float* cw = F.p->in[I_CONVW] + (size_t)l * 31 * BRW;
#pragma unroll
    for (int j = 0; j < 31; ++j) w[j] = cw[j * BRW + c];
    const float bias = F.p->in[I_CONVB][l * BRW + c];
    { const int cv = F.tid & 63, rg = F.tid >> 6;
      v4u ur[8], gr[8];
#pragma unroll
      for (int j = 0; j < 8; ++j) { const int i = rg + 8 * j, row = r0 - 15 + i;
          ur[j] = (v4u){0u, 0u, 0u, 0u}; gr[j] = ur[j];
          if (i < 62 && row >= seq_lo && row < seq_hi) { ur[j] = *(const v4u*)(U + (size_t)row * INC + U_AU + 8 * cv); gr[j] = *(const v4u*)(U + (size_t)row * INC + U_AG + 8 * cv); } }
#pragma unroll
      for (int j = 0; j < 8; ++j) { const int i = rg + 8 * j; const v4u u = ur[j], g = gr[j];
          f32x4 y0, y1;
          y0.x = bflo(u.x) * sigmoidf_(bflo(g.x)); y0.y = bfhi(u.x) * sigmoidf_(bfhi(g.x)); y0.z = bflo(u.y) * sigmoidf_(bflo(g.y)); y0.w = bfhi(u.y) * sigmoidf_(bfhi(g.y));
          y1.x = bflo(u.z) * sigmoidf_(bflo(g.z)); y1.y = bfhi(u.z) * sigmoidf_(bfhi(g.z)); y1.z = bflo(u.w) * sigmoidf_(bflo(g.w)); y1.w = bfhi(u.w) * sigmoidf_(bfhi(g.w));
          if (i < 62) { *(LAS f32x4*)(Y + i * 512 + 8 * cv) = y0; *(LAS f32x4*)(Y + i * 512 + 8 * cv + 4) = y1; } } }
    __syncthreads(); CP_END(1);
    {
      for (int tb = 0; tb < 4; ++tb) {
          float z[8];
#pragma unroll
          for (int k = 0; k < 8; ++k) z[k] = bias;
#pragma unroll
          for (int j = 0; j < 38; ++j) { const float yv = Y[(8 * tb + j) * 512 + c];
#pragma unroll
              for (int k = 0; k < 8; ++k) { const int tap = j - k; if (tap >= 0 && tap < 31) z[k] += w[tap] * yv; } }
#pragma unroll
          for (int k = 0; k < 8; ++k) Y[(8 * tb + k) * 512 + c] = z[k];
      } }
    __syncthreads(); CP_END(2);
    { const float* lg = F.p->in[I_CLNG] + l * BRW + 8 * F.lane; const float* lb = F.p->in[I_CLNB] + l * BRW + 8 * F.lane;
      const f32x4 g0 = *(const f32x4*)lg, g1 = *(const f32x4*)(lg + 4), b0 = *(const f32x4*)lb, b1 = *(const f32x4*)(lb + 4);
      for (int tk = F.wave; tk < 32; tk += 8) {
          f32x4 a = *(const LAS f32x4*)(Y + tk * 512 + 8 * F.lane), b = *(const LAS f32x4*)(Y + tk * 512 + 8 * F.lane + 4);
          const float mu = wave_sum((a.x + a.y) + (a.z + a.w) + (b.x + b.y) + (b.z + b.w)) * (1.0f / 512.0f);
          a = a - mu; b = b - mu;
          const float var = wave_sum((a.x * a.x + a.y * a.y) + (a.z * a.z + a.w * a.w) + (b.x * b.x + b.y * b.y) + (b.z * b.z + b.w * b.w)) * (1.0f / 512.0f);
          const float rs = 1.0f / sqrtf(var + EPS);
          a = a * rs * g0 + b0; b = b * rs * g1 + b1;
          v4u o; o.x = pk2(siluf_(a.x), siluf_(a.y)); o.y = pk2(siluf_(a.z), siluf_(a.w)); o.z = pk2(siluf_(b.x), siluf_(b.y)); o.w = pk2(siluf_(b.z), siluf_(b.w));
          *(v4u*)(BR + (size_t)(r0 + tk) * D + B_A + 8 * F.lane) = o;
      } }
    __syncthreads(); CP_END(4);
}

template <bool COMB> DI void pool_unit(Frame& F, int l, int pu) {
    const bf16* U = WSP(bf16, WS_U); bf16* BR = WSP(bf16, WS_BR);
    v4u cf[4], cr[4], cg[4];
    if (COMB) { const bf16* HF = WSP(bf16, WS_H); const bf16* HR = HF + (size_t)MT * BRW;
#pragma unroll
        for (int t = 0; t < 4; ++t) { const size_t ro = (size_t)(pu * 32 + F.wave + 8 * t);
            cf[t] = *(const v4u*)(HF + ro * BRW + 8 * F.lane); cr[t] = *(const v4u*)(HR + ro * BRW + 8 * F.lane);
            cg[t] = *(const v4u*)(U + ro * INC + U_RG + 8 * F.lane); } }
    LAS unsigned char* Pin = F.lds;
    LAS unsigned char* Yl = F.lds + 49152;
    const int r0 = pu * 32;
    const int seq_lo = (r0 < TL) ? (r0 / SEQ) * SEQ : TL + ((r0 - TL) / CTX) * CTX, seq_hi = seq_lo + ((r0 < TL) ? SEQ : CTX);
    { v4u pr[6];
#pragma unroll
      for (int j = 0; j < 6; ++j) { const int q = F.tid + 512 * j, i = q >> 6, cv = q & 63, row = r0 - 8 + i; pr[j] = (v4u){0u, 0u, 0u, 0u};
          if (q < 47 * 64 && row >= seq_lo && row < seq_hi) pr[j] = *(const v4u*)(U + (size_t)row * INC + U_P + 8 * cv); }
#pragma unroll
      for (int j = 0; j < 6; ++j) { const int q = F.tid + 512 * j, i = q >> 6, cv = q & 63;
          if (q < 47 * 64) *(LAS v4u*)(Pin + i * 1024 + cv * 16) = pr[j]; } }
    __syncthreads();
    { const int tk = F.tid >> 4, row = r0 + tk;
#pragma unroll
      for (int g = 0; g < 4; ++g) { const int cv = (F.tid & 15) + 16 * g, hw = 1 << g;
          const int lo = max(row - hw, seq_lo), hi = min(row + hw, seq_hi);
          float s[8];
#pragma unroll
          for (int k = 0; k < 8; ++k) s[k] = 0.f;
          for (int rr = lo; rr < hi; ++rr) { const v4u v = *(const LAS v4u*)(Pin + (rr - r0 + 8) * 1024 + cv * 16);
              s[0] += bflo(v.x); s[1] += bfhi(v.x); s[2] += bflo(v.y); s[3] += bfhi(v.y); s[4] += bflo(v.z); s[5] += bfhi(v.z); s[6] += bflo(v.w); s[7] += bfhi(v.w); }
          const float ic = 1.0f / (float)(hi - lo);
          const v4u c = *(const LAS v4u*)(Pin + (tk + 8) * 1024 + cv * 16);
          v4u o; o.x = pk2(s[0] * ic - bflo(c.x), s[1] * ic - bfhi(c.x)); o.y = pk2(s[2] * ic - bflo(c.y), s[3] * ic - bfhi(c.y));
          o.z = pk2(s[4] * ic - bflo(c.z), s[5] * ic - bfhi(c.z)); o.w = pk2(s[6] * ic - bflo(c.w), s[7] * ic - bfhi(c.w));
          *(LAS v4u*)(Yl + tk * 1040 + cv * 16) = o; } }
    __syncthreads();
    { const int g = F.wave >> 1, hf = F.wave & 1, fr = F.lane & 15, fq = F.lane >> 4;
      const bf16* WP = WSP(bf16, WS_SMALLW + SW_POOL);
      f32x4 acc[2][4];
#pragma unroll
      for (int m = 0; m < 2; ++m)
#pragma unroll
          for (int n = 0; n < 4; ++n) acc[m][n] = (f32x4){0.f, 0.f, 0.f, 0.f};
#pragma unroll
      for (int s = 0; s < 4; ++s) {
          bf16x8 ya[2], wb[4];
#pragma unroll
          for (int m = 0; m < 2; ++m) ya[m] = *(const LAS bf16x8*)(Yl + (m * 16 + fr) * 1040 + (g * 128 + s * 32 + 8 * fq) * 2);
#pragma unroll
          for (int n = 0; n < 4; ++n) wb[n] = *(const bf16x8*)(WP + (size_t)(g * 128 + hf * 64 + n * 16 + fr) * 128 + s * 32 + 8 * fq);
#pragma unroll
          for (int m = 0; m < 2; ++m)
#pragma unroll
              for (int n = 0; n < 4; ++n) acc[m][n] = __builtin_amdgcn_mfma_f32_16x16x32_bf16(wb[n], ya[m], acc[m][n], 0, 0, 0);
      }
      const float* ps = F.p->in[I_POOLS] + l * BRW;
#pragma unroll
      for (int m = 0; m < 2; ++m)
#pragma unroll
          for (int n = 0; n < 4; ++n) { const int col = g * 128 + hf * 64 + n * 16 + 4 * fq; const f32x4 sc = *(const f32x4*)(ps + col);
              v2u o; o.x = pk2(acc[m][n].x * sc.x, acc[m][n].y * sc.y); o.y = pk2(acc[m][n].z * sc.z, acc[m][n].w * sc.w);
#if DBG_POOLY
              o = *(const LAS v2u*)(Yl + (m * 16 + fr) * 1040 + col * 2);
#endif
              *(v2u*)(BR + (size_t)(r0 + m * 16 + fr) * D + B_D + col) = o; } }
    if (COMB) {
#pragma unroll
        for (int t = 0; t < 4; ++t) { const size_t row = (size_t)(pu * 32 + F.wave + 8 * t);
            v4u o; o.x = cvt_pk_bf16((bflo(cf[t].x) + bflo(cr[t].x)) * gelu_tanh(bflo(cg[t].x)), (bfhi(cf[t].x) + bfhi(cr[t].x)) * gelu_tanh(bfhi(cg[t].x)));
            o.y = cvt_pk_bf16((bflo(cf[t].y) + bflo(cr[t].y)) * gelu_tanh(bflo(cg[t].y)), (bfhi(cf[t].y) + bfhi(cr[t].y)) * gelu_tanh(bfhi(cg[t].y)));
            o.z = cvt_pk_bf16((bflo(cf[t].z) + bflo(cr[t].z)) * gelu_tanh(bflo(cg[t].z)), (bfhi(cf[t].z) + bfhi(cr[t].z)) * gelu_tanh(bfhi(cg[t].z)));
            o.w = cvt_pk_bf16((bflo(cf[t].w) + bflo(cr[t].w)) * gelu_tanh(bflo(cg[t].w)), (bfhi(cf[t].w) + bfhi(cr[t].w)) * gelu_tanh(bfhi(cg[t].w)));
            *(v4u*)(BR + row * D + B_B + 8 * F.lane) = o; }
    }
    __syncthreads();
}

#if PROBE_LRU
#define LP_T0() unsigned long long lp_t_ = __builtin_amdgcn_s_memrealtime()
#define LP_END(bit) do { const unsigned long long t1_ = __builtin_amdgcn_s_memrealtime(); if (PROBE_LRU & (bit)) { const unsigned long long dt_ = t1_ - lp_t_; while (__builtin_amdgcn_s_memrealtime() - t1_ < dt_) __builtin_amdgcn_s_sleep(4); } lp_t_ = __builtin_amdgcn_s_memrealtime(); } while (0)
#else
#define LP_T0() do { } while (0)
#define LP_END(bit) do { } while (0)
#endif
DI void lru_item(Frame& F, int l, int item) {
    const int b = item >> 4, h = (item >> 1) & 7, d = item & 1;
    const bf16* U = WSP(bf16, WS_U); bf16* BR = WSP(bf16, WS_BR); bf16* HF = WSP(bf16, WS_H); bf16* HR = HF + (size_t)MT * BRW;
    LAS float* XC = (LAS float*)F.lds;
    LAS float* A_ = (LAS float*)(F.lds + 34816);
    LAS float* B_ = (LAS float*)(F.lds + 69632);
    LAS float* CAR = (LAS float*)(F.lds + 104448);
    LAS float* CWL = (LAS float*)(F.lds + 108544);
    const int fr = F.lane & 15, fq = F.lane >> 4;
    if (F.tid < 320) CWL[F.tid] = (F.tid < 256) ? F.p->in[I_LCW][(size_t)l * 4 * BRW + (F.tid >> 6) * BRW + 64 * h + (F.tid & 63)] : F.p->in[I_LCB][l * BRW + 64 * h + (F.tid - 256)];
    __syncthreads();
    const bf16* WL = WSP(bf16, WS_SMALLW + SW_LRU);
    const int p1 = F.tid >> 2, cq1 = F.tid & 3;
#define LRU_TAPS(ci_) do { const int sg_ = (ci_) >= 2 ? 1 : 0, L_ = sg_ ? SEQ : CTX, r0_ = sg_ ? b * SEQ : TL + b * CTX, cb_ = ((ci_) - 2 * sg_) * 128; \
        const int ti_ = d ? (L_ - 1 - (cb_ + p1)) : (cb_ + p1); \
        _Pragma("unroll") for (int j = 0; j < 4; ++j) { const int tt_ = ti_ + j - 2; pu[j][0] = (v4u){0u, 0u, 0u, 0u}; pu[j][1] = pu[j][0]; \
            if (tt_ >= 0 && tt_ < L_) { const bf16* up_ = U + (size_t)(r0_ + tt_) * INC + U_RX + 64 * h + 16 * cq1; pu[j][0] = *(const v4u*)up_; pu[j][1] = *(const v4u*)(up_ + 8); } } } while (0)
    {
        bf16x8 wf[2][4][2];
#pragma unroll
        for (int q = 0; q < 2; ++q)
#pragma unroll
            for (int n = 0; n < 4; ++n)
#pragma unroll
                for (int s2 = 0; s2 < 2; ++s2) wf[q][n][s2] = *(const bf16x8*)(WL + ((size_t)((d * 2 + q) * 8 + h) * 64 + n * 16 + fr) * 64 + s2 * 32 + 8 * fq);
        float ba[4], bx[4], sp[4];
#pragma unroll
        for (int n = 0; n < 4; ++n) { const int ch = 64 * h + n * 16 + fr;
            ba[n] = F.p->in[I_LBA][(l * 2 + d) * BRW + ch]; bx[n] = F.p->in[I_LBX][(l * 2 + d) * BRW + ch];
            const float lam = F.p->in[I_LLAM][(l * 2 + d) * BRW + ch]; const float xl = __expf(-lam); sp[n] = (xl < 0.03f) ? xl * (1.0f - xl * (0.5f - xl * 0.33333333f)) : __logf(1.0f + xl); }
        float Hc = 0.f;
        v4u pu[4][2];
        LRU_TAPS(0);
#pragma unroll 1
        for (int ci = 0; ci < 34; ++ci) {
            const int seg = ci >= 2 ? 1 : 0, L = seg ? SEQ : CTX, row0 = seg ? b * SEQ : TL + b * CTX, cb = (ci - 2 * seg) * 128;
            const bool wr_out = (seg == 1) || (l == 0);
            LP_T0();

            { float xc[16];
#pragma unroll
              for (int k = 0; k < 16; ++k) xc[k] = CWL[256 + 16 * cq1 + k];
#pragma unroll
              for (int j = 0; j < 4; ++j) { const LAS float* wj = CWL + j * 64 + 16 * cq1; const v4u u0 = pu[j][0], u1 = pu[j][1];
                  xc[0] += wj[0] * bflo(u0.x); xc[1] += wj[1] * bfhi(u0.x); xc[2] += wj[2] * bflo(u0.y); xc[3] += wj[3] * bfhi(u0.y);
                  xc[4] += wj[4] * bflo(u0.z); xc[5] += wj[5] * bfhi(u0.z); xc[6] += wj[6] * bflo(u0.w); xc[7] += wj[7] * bfhi(u0.w);
                  xc[8] += wj[8] * bflo(u1.x); xc[9] += wj[9] * bfhi(u1.x); xc[10] += wj[10] * bflo(u1.y); xc[11] += wj[11] * bfhi(u1.y);
                  xc[12] += wj[12] * bflo(u1.z); xc[13] += wj[13] * bfhi(u1.z); xc[14] += wj[14] * bflo(u1.w); xc[15] += wj[15] * bfhi(u1.w); }
#pragma unroll
              for (int k = 0; k < 16; k += 4) *(LAS f32x4*)(XC + p1 * 68 + 16 * cq1 + k) = (f32x4){xc[k], xc[k + 1], xc[k + 2], xc[k + 3]}; }
            if (ci + 1 < 34) LRU_TAPS(ci + 1);
            LBAR(); LP_END(1);
            { f32x4 da[4], dx[4];
#pragma unroll
              for (int n = 0; n < 4; ++n) { da[n] = (f32x4){0.f, 0.f, 0.f, 0.f}; dx[n] = da[n]; }
#pragma unroll
              for (int s2 = 0; s2 < 2; ++s2) {
                  const LAS float* xp = XC + (16 * F.wave + fr) * 68 + s2 * 32 + 8 * fq;
                  const f32x4 x0 = *(const LAS f32x4*)xp, x1 = *(const LAS f32x4*)(xp + 4);
                  v4u pk; pk.x = cvt_pk_bf16(x0.x, x0.y); pk.y = cvt_pk_bf16(x0.z, x0.w); pk.z = cvt_pk_bf16(x1.x, x1.y); pk.w = cvt_pk_bf16(x1.z, x1.w);
                  const bf16x8 xa = __builtin_bit_cast(bf16x8, pk);
#pragma unroll
                  for (int n = 0; n < 4; ++n) { da[n] = __builtin_amdgcn_mfma_f32_16x16x32_bf16(xa, wf[0][n][s2], da[n], 0, 0, 0); dx[n] = __builtin_amdgcn_mfma_f32_16x16x32_bf16(xa, wf[1][n][s2], dx[n], 0, 0, 0); }
              }
#pragma unroll
              for (int n = 0; n < 4; ++n) { const int ch = n * 16 + fr; f32x4 av4, bv4;
#pragma unroll
                  for (int rg = 0; rg < 4; ++rg) { const int p = 16 * F.wave + 4 * fq + rg;
                      const float xv = XC[p * 68 + ch];
                      const float r = __builtin_amdgcn_rcpf(1.0f + __expf(-(da[n][rg] + ba[n]))), ig = __builtin_amdgcn_rcpf(1.0f + __expf(-(dx[n][rg] + bx[n])));
                      const float la = -8.0f * r * sp[n];
                      const float av = __expf(la), e2 = av * av;
                      const float om = (la > -0.05f) ? (-2.0f * la) * (1.0f + la * (1.0f + la * 0.66666667f)) : (1.0f - e2);
                      av4[rg] = av; bv4[rg] = __builtin_amdgcn_sqrtf(om) * ig * xv; }
                  *(LAS f32x4*)(A_ + ch * 132 + 16 * F.wave + 4 * fq) = av4; *(LAS f32x4*)(B_ + ch * 132 + 16 * F.wave + 4 * fq) = bv4; } }
            LDS_WAIT(); LP_END(2);
            f32x4 a4[4], b4[4];
#pragma unroll
            for (int k = 0; k < 4; ++k) { a4[k] = *(const LAS f32x4*)(A_ + F.lane * 132 + 16 * F.wave + 4 * k); b4[k] = *(const LAS f32x4*)(B_ + F.lane * 132 + 16 * F.wave + 4 * k); }
            { float P = 1.f, hl = 0.f;
#pragma unroll
              for (int q = 0; q < 16; ++q) { const float a = a4[q >> 2][q & 3], bb = b4[q >> 2][q & 3]; hl = a * hl + bb; P *= a; }
              CAR[(F.wave * 64 + F.lane) * 2] = P; CAR[(F.wave * 64 + F.lane) * 2 + 1] = hl; }
            LBAR();
            float cin = Hc;
            { float c = Hc;
#pragma unroll
              for (int w = 0; w < 8; ++w) { if (w == F.wave) cin = c; c = CAR[(w * 64 + F.lane) * 2] * c + CAR[(w * 64 + F.lane) * 2 + 1]; }
              Hc = c; }
            LP_END(4);
            { float hh = cin;
              if (d == 0) {
#pragma unroll
                  for (int q = 0; q < 16; ++q) { const int p = 16 * F.wave + q; hh = a4[q >> 2][q & 3] * hh + b4[q >> 2][q & 3];
                      if (wr_out) HF[(size_t)(row0 + cb + p) * BRW + 64 * h + F.lane] = (bf16)f2bf(hh); }
              } else {
#pragma unroll
                  for (int q = 0; q < 16; ++q) { const int p = 16 * F.wave + q; hh = a4[q >> 2][q & 3] * hh + b4[q >> 2][q & 3];
                      if (wr_out) HR[(size_t)(row0 + (L - 1 - (cb + p))) * BRW + 64 * h + F.lane] = (bf16)f2bf(hh); }
              } }
            LP_END(8);
        }
        VM_WAIT(); __syncthreads();
    }
#undef LRU_TAPS
}


DI void attn_task(Frame& F, int l, int ta, LAS float* wl) {
    const bf16* U = WSP(bf16, WS_U); bf16* BR = WSP(bf16, WS_BR);
    const int qrow = ta >> 1, kvh = ta & 1;
    const bool lat = qrow < TL;
    const int b = lat ? qrow / SEQ : (qrow - TL) / CTX, t = lat ? qrow % SEQ : 0;
    LAS float* qs = wl;
    LAS float* pp = wl + 256;
#pragma unroll
    for (int g = 0; g < 4; ++g) qs[g * 64 + F.lane] = bf2f(U[(size_t)qrow * INC + U_Q + (kvh * 4 + g) * 64 + F.lane]);
    LDS_WAIT();
    float m0 = -1e30f, m1 = -1e30f, m2 = -1e30f, m3 = -1e30f;
#pragma unroll 1
    for (int rr = 0; rr < 9; ++rr) {
        const int ki = rr * 64 + F.lane; bool valid; size_t krow;
        if (ki < 256) { valid = true; krow = (size_t)(TL + b * CTX + ki); }
        else { const int s = t - 128 + (ki - 256); valid = lat && (ki - 256 <= 256) && s >= 0 && s < SEQ; krow = (size_t)(b * SEQ + (valid ? s : 0)); }
        float d0 = 0.f, d1 = 0.f, d2 = 0.f, d3 = 0.f;
        if (valid) {
            const bf16* kp = U + krow * INC + U_K + kvh * 64;
#pragma unroll
            for (int c8 = 0; c8 < 8; ++c8) { const v4u kv = *(const v4u*)(kp + 8 * c8);
                const float kf[8] = {bflo(kv.x), bfhi(kv.x), bflo(kv.y), bfhi(kv.y), bflo(kv.z), bfhi(kv.z), bflo(kv.w), bfhi(kv.w)};
#pragma unroll
                for (int hq = 0; hq < 2; ++hq) { const f32x4 q0 = *(const LAS f32x4*)(qs + 0 * 64 + 8 * c8 + 4 * hq), q1 = *(const LAS f32x4*)(qs + 1 * 64 + 8 * c8 + 4 * hq), q2 = *(const LAS f32x4*)(qs + 2 * 64 + 8 * c8 + 4 * hq), q3 = *(const LAS f32x4*)(qs + 3 * 64 + 8 * c8 + 4 * hq);
                    const float k0 = kf[4 * hq], k1 = kf[4 * hq + 1], k2 = kf[4 * hq + 2], k3 = kf[4 * hq + 3];
                    d0 += q0.x * k0 + q0.y * k1 + q0.z * k2 + q0.w * k3; d1 += q1.x * k0 + q1.y * k1 + q1.z * k2 + q1.w * k3;
                    d2 += q2.x * k0 + q2.y * k1 + q2.z * k2 + q2.w * k3; d3 += q3.x * k0 + q3.y * k1 + q3.z * k2 + q3.w * k3; } }
        }
        const f32x4 sv = valid ? (f32x4){d0 * 0.125f, d1 * 0.125f, d2 * 0.125f, d3 * 0.125f} : (f32x4){-1e30f, -1e30f, -1e30f, -1e30f};
        m0 = fmaxf(m0, sv.x); m1 = fmaxf(m1, sv.y); m2 = fmaxf(m2, sv.z); m3 = fmaxf(m3, sv.w);
        *(LAS f32x4*)(pp + ki * 4) = sv;
    }
    const float* sinkp = F.p->in[I_SINK] + l * 8 + kvh * 4;
    const float k0s = sinkp[0], k1s = sinkp[1], k2s = sinkp[2], k3s = sinkp[3];
    m0 = fmaxf(wave_max(m0), k0s); m1 = fmaxf(wave_max(m1), k1s); m2 = fmaxf(wave_max(m2), k2s); m3 = fmaxf(wave_max(m3), k3s);
    float s0 = 0.f, s1 = 0.f, s2 = 0.f, s3 = 0.f;
    LDS_WAIT();
#pragma unroll 1
    for (int rr = 0; rr < 9; ++rr) {
        const int ki = rr * 64 + F.lane; f32x4 sv = *(const LAS f32x4*)(pp + ki * 4);
        sv.x = (sv.x > -1e29f) ? __expf(sv.x - m0) : 0.f; sv.y = (sv.y > -1e29f) ? __expf(sv.y - m1) : 0.f; sv.z = (sv.z > -1e29f) ? __expf(sv.z - m2) : 0.f; sv.w = (sv.w > -1e29f) ? __expf(sv.w - m3) : 0.f;
        s0 += sv.x; s1 += sv.y; s2 += sv.z; s3 += sv.w;
        *(LAS f32x4*)(pp + ki * 4) = sv;
    }
    const float ri0 = 1.0f / (wave_sum(s0) + __expf(k0s - m0)), ri1 = 1.0f / (wave_sum(s1) + __expf(k1s - m1)), ri2 = 1.0f / (wave_sum(s2) + __expf(k2s - m2)), ri3 = 1.0f / (wave_sum(s3) + __expf(k3s - m3));
    LDS_WAIT();
    float o0 = 0.f, o1 = 0.f, o2 = 0.f, o3 = 0.f;
    { const bf16* vp = U + (size_t)(TL + b * CTX) * INC + U_V + kvh * 64 + F.lane;
#pragma unroll 4
      for (int ki = 0; ki < 256; ++ki) { const f32x4 p4 = *(const LAS f32x4*)(pp + ki * 4); const float v = bf2f(vp[(size_t)ki * INC]); o0 += p4.x * v; o1 += p4.y * v; o2 += p4.z * v; o3 += p4.w * v; } }
    if (lat) { const int slo = max(t - 128, 0), shi = min(t + 128, SEQ - 1);
        const bf16* vp = U + (size_t)(b * SEQ) * INC + U_V + kvh * 64 + F.lane;
#pragma unroll 4
        for (int s = slo; s <= shi; ++s) { const f32x4 p4 = *(const LAS f32x4*)(pp + (256 + s - t + 128) * 4); const float v = bf2f(vp[(size_t)s * INC]); o0 += p4.x * v; o1 += p4.y * v; o2 += p4.z * v; o3 += p4.w * v; } }
    bf16* op = BR + (size_t)qrow * D + B_C + (kvh * 4) * 64 + F.lane;
    op[0] = (bf16)f2bf(o0 * ri0); op[64] = (bf16)f2bf(o1 * ri1); op[128] = (bf16)f2bf(o2 * ri2); op[192] = (bf16)f2bf(o3 * ri3);
    LDS_WAIT();
}

typedef float f32x16 __attribute__((ext_vector_type(16)));
constexpr int AK_RS = 144, AV_RS = 656;
constexpr int AV_OFF = 320 * AK_RS;
template <bool COMB> DI void attn_unit(Frame& F, int l, int un) {
    const bf16* U = WSP(bf16, WS_U); bf16* BR = WSP(bf16, WS_BR);
    LAS unsigned char* Kl = F.lds; LAS unsigned char* Vt = F.lds + AV_OFF;
    const bool isctx = un >= 1024;
    int b, blk, kvh;
    if (!isctx) { b = un >> 7; blk = (un & 127) >> 1; kvh = un & 1; } else { const int u2 = un - 1024; b = u2 >> 3; blk = (u2 >> 1) & 3; kvh = u2 & 1; }
    const int t0 = blk * 64;
    const int g = F.wave & 3, th = F.wave >> 2, r = F.lane & 31, h = F.lane >> 5;
    const int thu = __builtin_amdgcn_readfirstlane(th);
    const int qtok = t0 + th * 32 + r;
    const size_t qrow = (size_t)(isctx ? TL + b * CTX : b * SEQ) + qtok;
    bf16x8 qf[4];
#pragma unroll
    for (int sp = 0; sp < 4; ++sp) { const v4u q4 = *(const v4u*)(U + qrow * INC + U_Q + (kvh * 4 + g) * 64 + 16 * sp + 8 * h);
        v4u o; o.x = pk2(bflo(q4.x) * 0.125f, bfhi(q4.x) * 0.125f); o.y = pk2(bflo(q4.y) * 0.125f, bfhi(q4.y) * 0.125f); o.z = pk2(bflo(q4.z) * 0.125f, bfhi(q4.z) * 0.125f); o.w = pk2(bflo(q4.w) * 0.125f, bfhi(q4.w) * 0.125f);
        qf[sp] = __builtin_bit_cast(bf16x8, o); }
    float m = F.p->in[I_SINK][l * 8 + kvh * 4 + g], lsum = 1.0f;
    f32x16 O0, O1;
#pragma unroll
    for (int i = 0; i < 16; ++i) { O0[i] = 0.f; O1[i] = 0.f; }
    const int nseg = isctx ? 1 : 2;
    v4u kreg[5], vra[3], vrb[3];
    auto issue = [&](int seg) {
        const int nk = seg ? 320 : 256, kbase = seg ? (t0 - 128) : 0, klim = seg ? SEQ : CTX;
        const size_t krow0 = seg ? (size_t)b * SEQ : (size_t)(TL + b * CTX);
#pragma unroll
        for (int j = 0; j < 5; ++j) { const int q = F.tid + 512 * j, key = q >> 3, c = q & 7, kt = kbase + key;
            kreg[j] = (v4u){0u, 0u, 0u, 0u};
            if (q < nk * 8 && kt >= 0 && kt < klim) kreg[j] = *(const v4u*)(U + (krow0 + kt) * INC + U_K + kvh * 64 + 8 * c); }
#pragma unroll
        for (int j = 0; j < 3; ++j) { const int q = F.tid + 512 * j, kp = q >> 3, c = q & 7, k0_ = kbase + 2 * kp, k1_ = k0_ + 1;
            vra[j] = (v4u){0u, 0u, 0u, 0u}; vrb[j] = vra[j];
            if (q < nk * 4 && k0_ >= 0 && k0_ < klim) vra[j] = *(const v4u*)(U + (krow0 + k0_) * INC + U_V + kvh * 64 + 8 * c);
            if (q < nk * 4 && k1_ >= 0 && k1_ < klim) vrb[j] = *(const v4u*)(U + (krow0 + k1_) * INC + U_V + kvh * 64 + 8 * c); }
    };
    auto commit = [&](int seg) {
        const int nk = seg ? 320 : 256;
#pragma unroll
        for (int j = 0; j < 5; ++j) { const int q = F.tid + 512 * j, key = q >> 3, c = q & 7;
            if (q < nk * 8) *(LAS v4u*)(Kl + key * AK_RS + c * 16) = kreg[j]; }
#pragma unroll
        for (int j = 0; j < 3; ++j) { const int q = F.tid + 512 * j, kp = q >> 3, c = q & 7;
            if (q < nk * 4) { const v4u va = vra[j], vb = vrb[j];
                LAS unsigned* vp = (LAS unsigned*)(Vt + (8 * c) * AV_RS + ((kp ^ ((c & 3) << 3)) * 4));
                vp[0] = (va.x & 0xffffu) | (vb.x << 16); vp[AV_RS / 4] = (va.x >> 16) | (vb.x & 0xffff0000u);
                vp[2 * (AV_RS / 4)] = (va.y & 0xffffu) | (vb.y << 16); vp[3 * (AV_RS / 4)] = (va.y >> 16) | (vb.y & 0xffff0000u);
                vp[4 * (AV_RS / 4)] = (va.z & 0xffffu) | (vb.z << 16); vp[5 * (AV_RS / 4)] = (va.z >> 16) | (vb.z & 0xffff0000u);
                vp[6 * (AV_RS / 4)] = (va.w & 0xffffu) | (vb.w << 16); vp[7 * (AV_RS / 4)] = (va.w >> 16) | (vb.w & 0xffff0000u); } }
    };
    v4u cf[4], cr[4], cg[4];
    const size_t crow0 = (size_t)(isctx ? TL + b * CTX : b * SEQ) + t0 + 32 * kvh;
    issue(0);
    for (int seg = 0; seg < nseg; ++seg) {
        const int nk = seg ? 320 : 256;
        const int kbase = seg ? (t0 - 128) : 0;
        commit(seg);
        if (seg + 1 < nseg) issue(seg + 1);
        if (COMB && seg + 1 == nseg) {
            const bf16* HF = WSP(bf16, WS_H); const bf16* HR = HF + (size_t)MT * BRW;
#pragma unroll
            for (int t = 0; t < 4; ++t) { const size_t ro = crow0 + (size_t)(F.wave + 8 * t);
                cf[t] = *(const v4u*)(HF + ro * BRW + 8 * F.lane); cr[t] = *(const v4u*)(HR + ro * BRW + 8 * F.lane);
                cg[t] = *(const v4u*)(U + ro * INC + U_RG + 8 * F.lane); } }
        LBAR();
        for (int kt = 0; kt < nk / 32; ++kt) {
            bool need_mask = false;
            if (seg) {
                const int rel = kt - thu, s0 = kbase + kt * 32;
                if (rel < 0 || rel > 8 || s0 < 0 || s0 >= SEQ) continue;
                need_mask = (rel == 0) || (rel == 8);
            }
            f32x16 S;
#pragma unroll
            for (int i = 0; i < 16; ++i) S[i] = 0.f;
#pragma unroll
            for (int sp = 0; sp < 4; ++sp) { const bf16x8 ka = *(const LAS bf16x8*)(Kl + (kt * 32 + r) * AK_RS + (16 * sp + 8 * h) * 2);
                S = __builtin_amdgcn_mfma_f32_32x32x16_bf16(ka, qf[sp], S, 0, 0, 0); }
            if (need_mask) {
#pragma unroll
                for (int i = 0; i < 16; ++i) { const int s_ = kbase + kt * 32 + (i & 3) + 8 * (i >> 2) + 4 * h; const int d_ = s_ - qtok;
                    if (d_ > 128 || d_ < -128) S[i] = -1e30f; }
            }
            float mx = S[0];
#pragma unroll
            for (int i = 1; i < 16; ++i) mx = fmaxf(mx, S[i]);
            mx = fmaxf(mx, sx<32>(mx));
            if (__builtin_amdgcn_ballot_w64(mx > m) != 0ull) {
                const float mn = fmaxf(m, mx), alpha = __builtin_amdgcn_exp2f((m - mn) * 1.44269504f);
                lsum *= alpha; m = mn;
#pragma unroll
                for (int i = 0; i < 16; ++i) { O0[i] *= alpha; O1[i] *= alpha; }
            }
            const float mnl = m * 1.44269504f;
            float ps = 0.f;
#pragma unroll
            for (int i = 0; i < 16; ++i) { S[i] = __builtin_amdgcn_exp2f(__builtin_fmaf(S[i], 1.44269504f, -mnl)); ps += S[i]; }
            ps += sx<32>(ps);
            lsum += ps;
            bf16x8 pb[2];
#pragma unroll
            for (int s2 = 0; s2 < 2; ++s2) { v4u o; o.x = cvt_pk_bf16(S[8 * s2 + 0], S[8 * s2 + 1]); o.y = cvt_pk_bf16(S[8 * s2 + 2], S[8 * s2 + 3]); o.z = cvt_pk_bf16(S[8 * s2 + 4], S[8 * s2 + 5]); o.w = cvt_pk_bf16(S[8 * s2 + 6], S[8 * s2 + 7]);
                pb[s2] = __builtin_bit_cast(bf16x8, o); }
#pragma unroll
            for (int s2 = 0; s2 < 2; ++s2) {
                const LAS unsigned char* vb = Vt + (((kt * 32 + 16 * s2 + 4 * h) * 2) ^ (((r >> 3) & 3) << 5));
                const v2u a0 = *(const LAS v2u*)(vb + r * AV_RS), a1 = *(const LAS v2u*)(vb + r * AV_RS + 16);
                const v2u c0 = *(const LAS v2u*)(vb + (32 + r) * AV_RS), c1 = *(const LAS v2u*)(vb + (32 + r) * AV_RS + 16);
                const bf16x8 va0 = __builtin_bit_cast(bf16x8, (v4u){a0.x, a0.y, a1.x, a1.y}), va1 = __builtin_bit_cast(bf16x8, (v4u){c0.x, c0.y, c1.x, c1.y});
                O0 = __builtin_amdgcn_mfma_f32_32x32x16_bf16(va0, pb[s2], O0, 0, 0, 0);
                O1 = __builtin_amdgcn_mfma_f32_32x32x16_bf16(va1, pb[s2], O1, 0, 0, 0);
            }
        }
        LBAR();
    }
    const float inv = 1.0f / lsum;
    bf16* op = BR + qrow * D + B_C + (kvh * 4 + g) * 64 + 4 * h;
#pragma unroll
    for (int q4 = 0; q4 < 4; ++q4) {
        v2u o0, o1; o0.x = cvt_pk_bf16(O0[4 * q4] * inv, O0[4 * q4 + 1] * inv); o0.y = cvt_pk_bf16(O0[4 * q4 + 2] * inv, O0[4 * q4 + 3] * inv);
        o1.x = cvt_pk_bf16(O1[4 * q4] * inv, O1[4 * q4 + 1] * inv); o1.y = cvt_pk_bf16(O1[4 * q4 + 2] * inv, O1[4 * q4 + 3] * inv);
        *(v2u*)(op + 8 * q4) = o0; *(v2u*)(op + 32 + 8 * q4) = o1;
    }
    if (COMB) {
#pragma unroll
        for (int t = 0; t < 4; ++t) { const size_t row = crow0 + (size_t)(F.wave + 8 * t);
            v4u o; o.x = cvt_pk_bf16((bflo(cf[t].x) + bflo(cr[t].x)) * gelu_tanh(bflo(cg[t].x)), (bfhi(cf[t].x) + bfhi(cr[t].x)) * gelu_tanh(bfhi(cg[t].x)));
            o.y = cvt_pk_bf16((bflo(cf[t].y) + bflo(cr[t].y)) * gelu_tanh(bflo(cg[t].y)), (bfhi(cf[t].y) + bfhi(cr[t].y)) * gelu_tanh(bfhi(cg[t].y)));
            o.z = cvt_pk_bf16((bflo(cf[t].z) + bflo(cr[t].z)) * gelu_tanh(bflo(cg[t].z)), (bfhi(cf[t].z) + bfhi(cr[t].z)) * gelu_tanh(bfhi(cg[t].z)));
            o.w = cvt_pk_bf16((bflo(cf[t].w) + bflo(cr[t].w)) * gelu_tanh(bflo(cg[t].w)), (bfhi(cf[t].w) + bfhi(cr[t].w)) * gelu_tanh(bfhi(cg[t].w)));
            *(v4u*)(BR + row * D + B_B + 8 * F.lane) = o; }
    }
}

DI void mixer_phase(Frame& F, int l, int part) {
    const int nrow_out = (l == 0) ? MT : TL;
    const int nA = (l == 0) ? 1088 : 1024, nC = nrow_out / 32, nP = nrow_out / 32, nQ = MT / 64;
    const int total = part ? nA : 128 + nP + nC + nQ;
    LAS int* qslot = (LAS int*)(F.lds + LC_SCR);
    if (part) {
        const int x = F.bid & 7, j = F.bid >> 3;
        for (int it = F.bid; it < total; it += F.G) { F.lane = lane_id_asm(); F.tid = F.wave * 64 + F.lane;
            const int un = (it < 1024 && F.G == 256) ? (it & ~255) + (x >> 2) * 128 + ((x & 1) * 32 + j) * 2 + ((x >> 1) & 1) : it;
            attn_unit<true>(F, l, un); __syncthreads(); }
        return;
    }
    if (!part) {
        LAS float* rt = (LAS float*)(F.lds + LDS_MODV);
        for (int i = F.tid; i < 1024; i += 512) { const float ang = (float)(i >> 4) * powf(10000.0f, -(float)(i & 15) * (1.0f / 16.0f)); rt[i] = __cosf(ang); rt[1024 + i] = __sinf(ang); }
        __syncthreads();
    }
    for (;;) {
        if (F.tid == 0) qslot[0] = (int)__hip_atomic_fetch_add(F.ctl + CW_QUEUE + l * 64 + part * 16, 1u, __ATOMIC_RELAXED, __HIP_MEMORY_SCOPE_AGENT);
        __syncthreads();
        const int it = qslot[0];
        __syncthreads();
        if (it >= total) break;
        F.lane = lane_id_asm(); F.tid = F.wave * 64 + F.lane;
        if (part) attn_unit<true>(F, l, it);
        else if (it < 128) lru_item(F, l, it);
        else if (it < 128 + nQ) qk_unit(F, l, it - 128);
        else if (it < 128 + nQ + nP) pool_unit<false>(F, l, it - 128 - nQ);
        else conv_unit(F, l, it - 128 - nQ - nP);
        __syncthreads();
    }
}

DI int xcd_remap(int L, int total) { const int q = total / 8, r = total % 8, x = L % 8, off = L / 8; return (x < r ? x * (q + 1) : r * (q + 1) + (x - r) * q) + off; }

typedef f32x4 AccT[2][2][4][2];

struct SchedP2 {
    int G, c, nMmain, nmain, total, ldb_; const char* A; const char* B;
    DI bool next(int i, Unit& u) const {
        const int L = i * G + c; if (L >= total) return false;
        int pm, pn;
        if (L < nmain) pg8::tile_of(L, nMmain, INC / 256, pm, pn); else { const int r = L - nmain; pm = 128 + r / 3; pn = r % 3; }
        u.a = A + (size_t)pm * 256 * ldb_; u.b = B + (size_t)pn * 256 * ldb_; u.rows = nullptr; u.nvalid = 0; u.i0 = pm; u.i1 = pn; u.i2 = 0; u.i3 = 0; return true;
    }
};
struct SchedG {
    int G, c, nM, total; const char* A; const char* B;
    DI bool next(int i, Unit& u) const {
        const int L = i * G + c; if (L >= total) return false;
        int pm, pn; pg8::tile_of(L, nM, NGATE / 256, pm, pn);
        u.a = A + (size_t)pm * 256 * D; u.b = B + (size_t)pn * 256 * D; u.rows = nullptr; u.nvalid = 0; u.i0 = pm; u.i1 = pn; u.i2 = 0; u.i3 = 0; return true;
    }
};
struct EpiU {
    static constexpr bool PERM = true;
    bf16* U;
    DI bool operator()(AccT& acc, const Unit& u, int wr, int wc, int fr, int fq) const {
        const int row0 = u.i0 * 256 + wr * 64 + fr, pn = u.i1;
        bf16* base = U + pn * 256 + wc * 32 + 8 * fq;
#pragma unroll
        for (int ai = 0; ai < 2; ++ai)
#pragma unroll
            for (int m = 0; m < 4; ++m) { bf16* rowp = base + (size_t)(row0 + ai * 128 + m * 16) * INC;
#pragma unroll
                for (int bj = 0; bj < 2; ++bj) { const f32x4 v0 = acc[ai][bj][m][0] * (F8_WIN ? SC_GU : 1.0f), v1 = acc[ai][bj][m][1] * (F8_WIN ? SC_GU : 1.0f);
                    v4u w; w.x = cvt_pk_bf16(v0[0], v0[1]); w.y = cvt_pk_bf16(v0[2], v0[3]); w.z = cvt_pk_bf16(v1[0], v1[1]); w.w = cvt_pk_bf16(v1[2], v1[3]);
                    *(v4u*)(rowp + bj * 128) = w; } }
        return false;
    }
};
struct EpiG {
    static constexpr bool PERM = true;
    bf16* Gt; const float* bgate;
    DI bool operator()(AccT& acc, const Unit& u, int wr, int wc, int fr, int fq) const {
        const int row0 = u.i0 * 256 + wr * 64 + fr, colt = u.i1 * 256 + wc * 32 + 8 * fq;
        f32x4 bb[2][2];
#pragma unroll
        for (int bj = 0; bj < 2; ++bj) { bb[bj][0] = *(const f32x4*)(bgate + colt + bj * 128) * 1.44269504f + 7.99435344f; bb[bj][1] = *(const f32x4*)(bgate + colt + bj * 128 + 4) * 1.44269504f + 7.99435344f; }
        unsigned char* gp = (unsigned char*)Gt + (size_t)u.i1 * 256 + (wc * 4 + fq) * 16;
#pragma unroll
        for (int ai = 0; ai < 2; ++ai) {
#pragma unroll
            for (int m = 0; m < 4; ++m) {
                unsigned wq[2][2];
#pragma unroll
                for (int bj = 0; bj < 2; ++bj) {
                    f32x4 v0 = acc[ai][bj][m][0] * (-SC_GU * 1.44269504f) - bb[bj][0], v1 = acc[ai][bj][m][1] * (-SC_GU * 1.44269504f) - bb[bj][1];
#pragma unroll
                    for (int k = 0; k < 4; ++k) { v0[k] = fmaxf(__builtin_amdgcn_rcpf(__builtin_amdgcn_exp2f(v0[k]) + (1.0f / 255.0f)), 1.0f); v1[k] = fmaxf(__builtin_amdgcn_rcpf(__builtin_amdgcn_exp2f(v1[k]) + (1.0f / 255.0f)), 1.0f); }
                    unsigned w0 = 0u, w1 = 0u;
                    w0 = __builtin_amdgcn_cvt_pk_u8_f32(v0[0], 0, w0); w0 = __builtin_amdgcn_cvt_pk_u8_f32(v0[1], 1, w0); w0 = __builtin_amdgcn_cvt_pk_u8_f32(v0[2], 2, w0); w0 = __builtin_amdgcn_cvt_pk_u8_f32(v0[3], 3, w0);
                    w1 = __builtin_amdgcn_cvt_pk_u8_f32(v1[0], 0, w1); w1 = __builtin_amdgcn_cvt_pk_u8_f32(v1[1], 1, w1); w1 = __builtin_amdgcn_cvt_pk_u8_f32(v1[2], 2, w1); w1 = __builtin_amdgcn_cvt_pk_u8_f32(v1[3], 3, w1);
                    wq[bj][0] = w0; wq[bj][1] = w1;
                }
                *(v4u*)(gp + (size_t)(row0 + ai * 128 + m * 16) * NGATE) = (v4u){wq[0][0], wq[0][1], wq[1][0], wq[1][1]};
            }
            asm volatile("" ::: "memory");
        }
        return false;
    }
};

struct SchedP4 {
    int G, c, nM, ntiles; const char* A; const char* B;
    DI bool next(int i, Unit& u) const {
        const int j = i >> 2, kb = i & 3, L = j * G + c; if (L >= ntiles) return false;
        int pm, pn; pg8::tile_of(L, nM, 8, pm, pn);
        u.a = A + (size_t)pm * 256 * (D * 2) + kb * (BRW * 2); u.b = B + ((size_t)kb * D + pn * 256) * (BRW * 2); u.rows = nullptr; u.nvalid = 0; u.i0 = pm; u.i1 = pn; u.i2 = kb; u.i3 = 0; return true;
    }
};
struct EpiHorner {
    static constexpr bool PERM = true;
    const bf16* Gt; bf16* ACC;
    DI bool operator()(AccT& acc, const Unit& u, int wr, int wc, int fr, int fq) const {
        const int row0 = u.i0 * 256 + wr * 64 + fr, col0 = u.i1 * 256 + wc * 32 + 8 * fq, kb = u.i2;
        const unsigned char* gp = (const unsigned char*)Gt + (size_t)kb * D + (size_t)u.i1 * 256 + (wc * 4 + fq) * 16;
#pragma unroll
        for (int ai = 0; ai < 2; ++ai) {
            v4u g0v[4], g1v[4];
#pragma unroll
            for (int m = 0; m < 4; ++m) { const size_t row = (size_t)(row0 + ai * 128 + m * 16);
                g0v[m] = *(const v4u*)(gp + row * NGATE);
                g1v[m] = (kb < 3) ? *(const v4u*)(gp + row * NGATE + D) : (v4u){0x01010101u, 0x01010101u, 0x01010101u, 0x01010101u}; }
#pragma unroll
            for (int m = 0; m < 4; ++m) { const size_t row = (size_t)(row0 + ai * 128 + m * 16);
#pragma unroll
                for (int bj = 0; bj < 2; ++bj) {
                    const unsigned gx = bj ? g0v[m].z : g0v[m].x, gy = bj ? g0v[m].w : g0v[m].y, hx = bj ? g1v[m].z : g1v[m].x, hy = bj ? g1v[m].w : g1v[m].y;
                    float s[8] = {(float)(gx & 0xffu), (float)((gx >> 8) & 0xffu), (float)((gx >> 16) & 0xffu), (float)(gx >> 24), (float)(gy & 0xffu), (float)((gy >> 8) & 0xffu), (float)((gy >> 16) & 0xffu), (float)(gy >> 24)};
                    const float t[8] = {(float)(hx & 0xffu), (float)((hx >> 8) & 0xffu), (float)((hx >> 16) & 0xffu), (float)(hx >> 24), (float)(hy & 0xffu), (float)((hy >> 8) & 0xffu), (float)((hy >> 16) & 0xffu), (float)(hy >> 24)};
#pragma unroll
                    for (int k = 0; k < 8; ++k) { if (kb < 3) s[k] *= __builtin_amdgcn_rcpf(t[k]); else s[k] *= (1.0f / 255.0f); }
                    f32x4 v0 = acc[ai][bj][m][0], v1 = acc[ai][bj][m][1];
                    v0[0] *= s[0]; v0[1] *= s[1]; v0[2] *= s[2]; v0[3] *= s[3]; v1[0] *= s[4]; v1[1] *= s[5]; v1[2] *= s[6]; v1[3] *= s[7];
                    acc[ai][bj][m][0] = v0; acc[ai][bj][m][1] = v1;
                    if (kb == 3) { v4u w; w.x = cvt_pk_bf16(v0[0], v0[1]); w.y = cvt_pk_bf16(v0[2], v0[3]); w.z = cvt_pk_bf16(v1[0], v1[1]); w.w = cvt_pk_bf16(v1[2], v1[3]);
                        *(v4u*)(ACC + row * D + col0 + bj * 128) = w; }
                } }
            asm volatile("" ::: "memory");
        }
        return kb < 3;
    }
};

struct SchedP5 {
    int G, c, nM, ntiles; const char* A; const char* B;
    DI bool next(int i, Unit& u) const {
        const int L = i * G + c; if (L >= ntiles) return false;
        int pm, pn; pg8::tile_of(L, nM, 8, pm, pn);
        u.a = A + (size_t)pm * 256 * (F8_WOUT ? D : D * 2); u.b = B + (size_t)pn * 256 * (F8_WOUT ? D : D * 2); u.rows = nullptr; u.nvalid = 0; u.i0 = pm; u.i1 = pn; u.i2 = 0; u.i3 = 0; return true;
    }
};
template <bool SB> struct EpiRes {
    static constexpr bool PERM = true;
    const float* xl; const float* xc; bf16* XB; const float* modg;
    DI bool operator()(AccT& acc, const Unit& u, int wr, int wc, int fr, int fq) const {
        const int pm = u.i0; const bool lat = pm < 128; const int bidx = lat ? pm / 16 : 8;
        const float* src = lat ? xl + (size_t)pm * 256 * D : xc + (size_t)(pm - 128) * 256 * D;
        bf16* xb = XB + (size_t)pm * 256 * D;
        const int col0 = u.i1 * 256 + wc * 32 + 8 * fq, r0 = wr * 64 + fr;
        const float* g1 = modg + (size_t)bidx * MODW;
        f32x4 gv[2][2];
#pragma unroll
        for (int bj = 0; bj < 2; ++bj)
#pragma unroll
            for (int n = 0; n < 2; ++n) gv[bj][n] = *(const f32x4*)(g1 + col0 + bj * 128 + n * 4);
#pragma unroll
        for (int ai = 0; ai < 2; ++ai) {
            f32x4 bsv[4][2][2];
#pragma unroll
            for (int m = 0; m < 4; ++m) { const size_t off = (size_t)(r0 + ai * 128 + m * 16) * D + col0;
#pragma unroll
                for (int bj = 0; bj < 2; ++bj) {
                    if (SB) { const v4u t = *(const v4u*)(xb + off + bj * 128);
                        bsv[m][bj][0] = (f32x4){bflo(t.x), bfhi(t.x), bflo(t.y), bfhi(t.y)}; bsv[m][bj][1] = (f32x4){bflo(t.z), bfhi(t.z), bflo(t.w), bfhi(t.w)}; }
                    else { bsv[m][bj][0] = *(const f32x4*)(src + off + bj * 128); bsv[m][bj][1] = *(const f32x4*)(src + off + bj * 128 + 4); } } }
#pragma unroll
            for (int m = 0; m < 4; ++m) { const size_t off = (size_t)(r0 + ai * 128 + m * 16) * D + col0;
#pragma unroll
                for (int bj = 0; bj < 2; ++bj) {
                    const f32x4 v0 = bsv[m][bj][0] + gv[bj][0] * (acc[ai][bj][m][0] * (F8_WOUT ? SC_GU : 1.0f)), v1 = bsv[m][bj][1] + gv[bj][1] * (acc[ai][bj][m][1] * (F8_WOUT ? SC_GU : 1.0f));
                    v4u w; w.x = cvt_pk_bf16(v0[0], v0[1]); w.y = cvt_pk_bf16(v0[2], v0[3]); w.z = cvt_pk_bf16(v1[0], v1[1]); w.w = cvt_pk_bf16(v1[2], v1[3]);
                    *(v4u*)(xb + off + bj * 128) = w; } }
            asm volatile("" ::: "memory");
        }
        return false;
    }
};

struct SchedMoe {
    int G, c, NT, mode; const LAS int* tpre; const LAS int* cnt;
    const char* A; const char* B; const int* rowlist; int lda_b, ldb_b;
    DI bool next(int i, Unit& u) const {
        const int L0 = i * G + c; if (L0 >= NT * 8) return false;
        const int L = xcd_remap(L0, NT * 8);
        const int rt = L >> 3, ct = L & 7; int e = 0;
#pragma unroll
        for (int k = 1; k < NE; ++k) e += (tpre[k] <= rt) ? 1 : 0;
        e = __builtin_amdgcn_readfirstlane(e);
        const int rb = __builtin_amdgcn_readfirstlane(rt - tpre[e]);
        u.nvalid = __builtin_amdgcn_readfirstlane(min(256, cnt[e] - rb * 256)); u.rows = rowlist + (size_t)e * ECAP + rb * 256;
        if (mode == 0) { u.a = A; u.b = B + ((size_t)e * 2048 + ct * 256) * ldb_b; }
        else { u.a = A + (size_t)rt * 256 * lda_b; u.b = B + ((size_t)e * 2048 + ct * 256) * ldb_b; }
        u.i0 = rt; u.i1 = ct; u.i2 = e; u.i3 = rb; return true;
    }
};
struct EpiSwiglu {
    static constexpr bool PERM = true;
    unsigned char* HB;
    DI bool operator()(AccT& acc, const Unit& u, int wr, int wc, int fr, int fq) const {
        const int row0 = u.i0 * 256 + wr * 64 + fr, col0 = u.i1 * 128 + wc * 32 + 8 * fq;
#pragma unroll
        for (int ai = 0; ai < 2; ++ai)
#pragma unroll
            for (int m = 0; m < 4; ++m) {
                f32x4 g0 = acc[ai][0][m][0], g1 = acc[ai][0][m][1]; const f32x4 u0 = acc[ai][1][m][0], u1 = acc[ai][1][m][1];
#pragma unroll
                for (int k = 0; k < 4; ++k) { const float a0 = g0[k] * SC_GU, a1 = g1[k] * SC_GU; g0[k] = a0 * __builtin_amdgcn_rcpf(1.0f + __expf(-a0)) * (u0[k] * SC_GU); g1[k] = a1 * __builtin_amdgcn_rcpf(1.0f + __expf(-a1)) * (u1[k] * SC_GU); }
                v2u w; w.x = fp8x4(g0[0] * S_HB, g0[1] * S_HB, g0[2] * S_HB, g0[3] * S_HB); w.y = fp8x4(g1[0] * S_HB, g1[1] * S_HB, g1[2] * S_HB, g1[3] * S_HB);
                *(v2u*)(HB + (size_t)(row0 + ai * 128 + m * 16) * DE + col0) = w; }
        return false;
    }
};
struct EpiDown {
    static constexpr bool PERM = true;
    bf16* O; const float* wlist;
    DI bool operator()(AccT& acc, const Unit& u, int wr, int wc, int fr, int fq) const {
        const int rl0 = wr * 64 + fr, col0 = u.i1 * 256 + wc * 32 + 8 * fq;
        const float* wp = wlist + (size_t)u.i2 * ECAP + u.i3 * 256;
#pragma unroll
        for (int ai = 0; ai < 2; ++ai)
#pragma unroll
            for (int m = 0; m < 4; ++m) { const int rl = rl0 + ai * 128 + m * 16; const float w = rl < u.nvalid ? wp[rl] * SC_DN : 0.f;
                bf16* rowp = O + (size_t)(u.i0 * 256 + rl) * D + col0;
#pragma unroll
                for (int bj = 0; bj < 2; ++bj) { const f32x4 v0 = acc[ai][bj][m][0] * w, v1 = acc[ai][bj][m][1] * w;
                    v4u q; q.x = cvt_pk_bf16(v0[0], v0[1]); q.y = cvt_pk_bf16(v0[2], v0[3]); q.z = cvt_pk_bf16(v1[0], v1[1]); q.w = cvt_pk_bf16(v1[2], v1[3]);
                    *(v4u*)(rowp + bj * 128) = q; } }
        return false;
    }
};


DI void dbg_checksum(Frame& F, const unsigned* p, size_t nwords, unsigned* cs) {
    unsigned h = 0;
    for (size_t i = (size_t)F.bid * 512 + F.tid; i < nwords; i += (size_t)F.G * 512) h += p[i] * 2654435761u + (unsigned)i;
    __hip_atomic_fetch_add(cs, h, __ATOMIC_RELAXED, __HIP_MEMORY_SCOPE_AGENT);
}
constexpr int NPH = 20;
#if MK_PER_PHASE
#define GRID_BAR() do { } while (0)
#else
#define GRID_BAR() xcd_barrier(bar)
#endif
#define IN(k) (lo <= (k) && (k) < hi)
#define PB() do { F.lane = lane_id_asm(); F.tid = F.wave * 64 + F.lane; { const __attribute__((address_space(4))) char* ka_ = (const __attribute__((address_space(4))) char*)__builtin_amdgcn_kernarg_segment_ptr(); asm volatile("" : "+s"(ka_)); F.p = (const __attribute__((address_space(4))) Params*)ka_; } } while (0)
#define SEAM(k) do { if (IN(k) && IN((k) + 1)) GRID_BAR(); } while (0)
#if PROBE_MASK
#define PR_BEGIN() do { pr_t0 = __builtin_amdgcn_s_memrealtime(); } while (0)
#define PR_END(j) do { if ((PROBE_MASK >> (j)) & 1) { const unsigned long long t1_ = __builtin_amdgcn_s_memrealtime(); const unsigned long long dt_ = t1_ - pr_t0; while (__builtin_amdgcn_s_memrealtime() - t1_ < dt_) __builtin_amdgcn_s_sleep(8); } } while (0)
#else
#define PR_BEGIN() do { } while (0)
#define PR_END(j) do { } while (0)
#endif
template <int l> DI void run_layer(Frame& F, const XcdBarrier& bar, const int lo, const int hi, unsigned long long& pr_t0) {
    LAS unsigned char* ring = F.lds; const float* mod = WSP(float, WS_MOD);
    constexpr int pb = 1 + 9 * l; PR_BEGIN();
        if (IN(pb + 0)) { PB(); norm_phase(F, l, l == 0 ? 0 : 1); PB(); if (l > 0) convert_weights(F, l); }
        SEAM(pb + 0); PR_END(1); PR_BEGIN();
        if (IN(pb + 1)) {
            { SchedP2 S; S.G = F.G; S.c = F.bid; S.nMmain = (l == 0) ? 136 : 128; S.nmain = S.nMmain * (INC / 256); S.total = S.nmain + ((l == 0) ? 0 : 24);
#if F8_WIN
              S.A = (const char*)WSP(unsigned char, WS_H8); S.B = (const char*)WSP(unsigned char, WS_W2); S.ldb_ = D;
              EpiU E; E.U = WSP(bf16, WS_U);
              pg8::gemm_phase<EpiU, SchedP2, false, true>(ring, F.wave, D / 2, D, D, S, E); }
#else
              S.A = (const char*)WSP(bf16, WS_H); S.B = (const char*)WSP(bf16, WS_W2); S.ldb_ = D * 2;
              EpiU E; E.U = WSP(bf16, WS_U);
              pg8::gemm_phase<EpiU, SchedP2, false, false>(ring, F.wave, D, D * 2, D * 2, S, E); }
#endif
            { SchedG S; S.G = F.G; S.c = F.bid; S.nM = (l == 0) ? 136 : 128; S.total = S.nM * (NGATE / 256);
              S.A = (const char*)WSP(unsigned char, WS_H8); S.B = (const char*)WSP(unsigned char, WS_W2) + W2G_OFF;
              EpiG E; E.Gt = WSP(bf16, WS_G); E.bgate = F.p->in[I_BGATE] + (size_t)l * NGATE;
              pg8::gemm_phase<EpiG, SchedG, false, true>(ring, F.wave, D / 2, D, D, S, E); }
        }
        SEAM(pb + 1); PR_END(2); PR_BEGIN();
        PR_END(3); PR_BEGIN();
        if (IN(pb + 3)) { PB();
#if PROBE_MX
            unsigned long long mx_t_ = __builtin_amdgcn_s_memrealtime();
#define MX_END(bit) do { const unsigned long long t1_ = __builtin_amdgcn_s_memrealtime(); if (PROBE_MX & (bit)) { const unsigned long long dt_ = t1_ - mx_t_; while (__builtin_amdgcn_s_memrealtime() - t1_ < dt_) __builtin_amdgcn_s_sleep(4); } mx_t_ = __builtin_amdgcn_s_memrealtime(); } while (0)
#else
#define MX_END(bit) do { } while (0)
#endif
            mixer_phase(F, l, 0); MX_END(1); GRID_BAR(); MX_END(2); PB(); mixer_phase(F, l, 1); MX_END(4); }
        SEAM(pb + 3); PR_END(4); PR_BEGIN();
        const int nM = (l == 0) ? 136 : 128;
        if (IN(pb + 4)) {
            SchedP4 S; S.G = F.G; S.c = F.bid; S.nM = nM; S.ntiles = nM * 8; S.A = (const char*)WSP(bf16, WS_BR); S.B = (const char*)WSP(bf16, WS_WB);
            EpiHorner E; E.Gt = WSP(bf16, WS_G); E.ACC = WSP(bf16, WS_U);
            pg8::gemm_phase<EpiHorner, SchedP4, false, false>(ring, F.wave, BRW, D * 2, BRW * 2, S, E);
        }
        SEAM(pb + 4); PR_END(5); PR_BEGIN();
        if (IN(pb + 5)) {
            SchedP5 S; S.G = F.G; S.c = F.bid; S.nM = nM; S.ntiles = nM * 8; S.A = (const char*)WSP(bf16, WS_U); S.B = (const char*)WSP(bf16, WS_WO);
            EpiRes<(l > 0)> E; E.xl = F.p->in[I_X]; E.xc = F.p->in[I_CTX]; E.XB = WSP(bf16, WS_XB); E.modg = mod + (size_t)l * 9 * MODW + MO_G1;
#if F8_WOUT
            pg8::gemm_phase<EpiRes<(l > 0)>, SchedP5, false, true>(ring, F.wave, D / 2, D, D, S, E);
#else
            pg8::gemm_phase<EpiRes<(l > 0)>, SchedP5, false, false>(ring, F.wave, D, D * 2, D * 2, S, E);
#endif
        }
        SEAM(pb + 5); PR_END(6); PR_BEGIN();
        if (IN(pb + 6)) { PB(); router_phase(F, l); GRID_BAR(); PB(); router_assign(F, l); }
        SEAM(pb + 6); PR_END(7); PR_BEGIN();
        if (IN(pb + 7)) {
            PB();
            LAS int* tpre = (LAS int*)(F.lds + LC_SCR + 4096); LAS int* cn = tpre + 32;
            if (F.tid == 0) { int acc = 0; for (int e = 0; e < NE; ++e) { const int c = (int)__hip_atomic_load(F.ctl + CW_CNT + (l * 16 + e) * 64, __ATOMIC_RELAXED, __HIP_MEMORY_SCOPE_AGENT); cn[e] = c; tpre[e] = acc; acc += (c + 255) >> 8; } tpre[NE] = acc; }
            __syncthreads();
            SchedMoe S; S.G = F.G; S.c = F.bid; S.NT = __builtin_amdgcn_readfirstlane(tpre[NE]); S.tpre = tpre; S.cnt = cn; S.rowlist = (const int*)(F.ws + WS_LIST + LIST_ROW);
            S.mode = 0; S.A = (const char*)WSP(unsigned char, WS_H); S.B = (const char*)WSP(unsigned char, WS_WGU); S.lda_b = D; S.ldb_b = D;
            EpiSwiglu E; E.HB = WSP(unsigned char, WS_HB);
            pg8::gemm_phase<EpiSwiglu, SchedMoe, true, true>(ring, F.wave, D / 2, D, D, S, E);
        }
        SEAM(pb + 7); PR_END(8); PR_BEGIN();
        if (IN(pb + 8)) {
            PB();
            LAS int* tpre = (LAS int*)(F.lds + LC_SCR + 4096); LAS int* cn = tpre + 32;
            if (F.tid == 0) { int acc = 0; for (int e = 0; e < NE; ++e) { const int c = (int)__hip_atomic_load(F.ctl + CW_CNT + (l * 16 + e) * 64, __ATOMIC_RELAXED, __HIP_MEMORY_SCOPE_AGENT); cn[e] = c; tpre[e] = acc; acc += (c + 255) >> 8; } tpre[NE] = acc; }
            __syncthreads();
            SchedMoe S; S.G = F.G; S.c = F.bid; S.NT = __builtin_amdgcn_readfirstlane(tpre[NE]); S.tpre = tpre; S.cnt = cn; S.rowlist = (const int*)(F.ws + WS_LIST + LIST_ROW);
            S.mode = 1; S.A = (const char*)WSP(unsigned char, WS_HB); S.B = (const char*)WSP(unsigned char, WS_WD); S.lda_b = DE; S.ldb_b = DE;
            EpiDown E; E.O = WSP(bf16, WS_O); E.wlist = (const float*)(F.ws + WS_LIST + LIST_W);
            pg8::gemm_phase<EpiDown, SchedMoe, false, true>(ring, F.wave, DE / 2, DE, DE, S, E);
        }
        SEAM(pb + 8); PR_END(9); PR_BEGIN();
    }

__global__ void __launch_bounds__(512, 2) mk_fwd(Params prm) {
    extern __shared__ __attribute__((aligned(16))) unsigned char lds_raw[];
    Frame F;
    F.lds = (LAS unsigned char*)lds_raw; F.p = (const __attribute__((address_space(4))) Params*)__builtin_amdgcn_kernarg_segment_ptr(); F.ws = prm.ws; F.ctl = (unsigned*)(prm.ws + WS_CTL);
    F.tid = threadIdx.x; F.lane = F.tid & 63; F.wave = __builtin_amdgcn_readfirstlane(F.tid >> 6); F.G = gridDim.x; F.bid = blockIdx.x;
    for (int u = F.tid; u < (LDS_BYTES - LDSCTL_OFF) / 4; u += 512) ((LAS unsigned*)(F.lds + LDSCTL_OFF))[u] = 0u;
    __syncthreads();
#if !MK_PER_PHASE
    XcdBarrier bar = xcd_barrier_post(F.ctl + CW_BAR, (volatile LAS unsigned*)(F.lds + LDSCTL_OFF));
#else
    XcdBarrier bar; bar.bar = nullptr; bar.x = 0; bar.st = nullptr;
#endif
    const int lo = prm.ph_lo, hi = prm.ph_hi;
    unsigned long long pr_t0 = 0; (void)pr_t0;
    LAS unsigned char* ring = F.lds;
    const float* mod = WSP(float, WS_MOD);

    PR_BEGIN();
    if (IN(0)) { PB(); mod_gemv(F); PB(); convert_weights(F, 0); }
    SEAM(0); PR_END(0);
    run_layer<0>(F, bar, lo, hi, pr_t0);
    run_layer<1>(F, bar, lo, hi, pr_t0);
    PR_BEGIN();
    if (IN(NPH - 1)) { PB(); norm_phase(F, DEPTH - 1, 2); }
    PR_END(10);
}

#ifndef DBG_DUMP
#endif
__global__ void dbg_dump(const bf16* a, const bf16* b, float* o, size_t n) {
    for (size_t i = (size_t)blockIdx.x * blockDim.x + threadIdx.x; i < n; i += (size_t)gridDim.x * blockDim.x) o[i] = bf2f(a[i]) + 3.0f * bf2f(b[i]);
}
__global__ void dbg_dump2(const bf16* br, int c0, int c1, float* o, size_t n) {
    for (size_t i = (size_t)blockIdx.x * blockDim.x + threadIdx.x; i < n; i += (size_t)gridDim.x * blockDim.x) { const size_t row = i >> 9; const int c = (int)(i & 511);
        o[i] = (row < (size_t)MT) ? bf2f(br[row * D + c0 + c]) + 3.0f * bf2f(br[row * D + c1 + c]) : 0.f; }
}
extern "C" void kernel_launch(void* const* d_in, const int* in_sizes, int n_in, void* d_out, int out_size, void* d_ws, size_t ws_size, hipStream_t stream) {
    static int grid = 0;
    if (grid == 0) {
        if (n_in != 34 || out_size != TL * D || ws_size < WS_END) { fprintf(stderr, "kernel_launch: unexpected shapes (n_in %d out %d ws %zu, need ws >= %zu)\n", n_in, out_size, ws_size, (size_t)WS_END); grid = -1; return; }
        int dev = 0, cus = 0, per_cu = 0;
        if (hipGetDevice(&dev) != hipSuccess || hipDeviceGetAttribute(&cus, hipDeviceAttributeMultiprocessorCount, dev) != hipSuccess) { grid = -1; return; }
        if (hipFuncSetAttribute((const void*)mk_fwd, hipFuncAttributeMaxDynamicSharedMemorySize, LDS_BYTES) != hipSuccess) { fprintf(stderr, "kernel_launch: hipFuncSetAttribute failed\n"); grid = -1; return; }
        if (hipOccupancyMaxActiveBlocksPerMultiprocessor(&per_cu, (const void*)mk_fwd, 512, LDS_BYTES) != hipSuccess || per_cu < 1) fprintf(stderr, "kernel_launch: occupancy query says %d\n", per_cu);
        (void)hipGetLastError();
        grid = cus;
        if (grid != 256) { fprintf(stderr, "kernel_launch: built for 256 CUs, device has %d\n", cus); grid = -1; return; }
    }
    if (grid < 0) return;
    (void)hipMemsetAsync((char*)d_ws + WS_CTL, 0, CTL_BYTES, stream);
    Params p{};
    for (int i = 0; i < 34; ++i) p.in[i] = (const float*)d_in[i];
    p.out = (float*)d_out; p.ws = (unsigned char*)d_ws;
#if MK_PER_PHASE
    for (int ph = 0; ph < DBG_PH_HI; ++ph) { p.ph_lo = ph; p.ph_hi = ph + 1; hipLaunchKernelGGL(mk_fwd, dim3(grid), dim3(512), LDS_BYTES, stream, p); }
#if DBG_DUMP == 1
    hipLaunchKernelGGL(dbg_dump, dim3(2048), dim3(256), 0, stream, (const bf16*)((char*)d_ws + WS_U), (const bf16*)((char*)d_ws + WS_G), (float*)d_out, (size_t)TL * D);
#endif
#else
    p.ph_lo = 0; p.ph_hi = DBG_PH_HI;
    hipLaunchKernelGGL(mk_fwd, dim3(grid), dim3(512), LDS_BYTES, stream, p);
#if DBG_DUMP == 1
    hipLaunchKernelGGL(dbg_dump, dim3(2048), dim3(256), 0, stream, (const bf16*)((char*)d_ws + WS_G), (const bf16*)((char*)d_ws + WS_U), (float*)d_out, (size_t)TL * D);
#endif
#if DBG_DUMP == 2
    hipLaunchKernelGGL(dbg_dump2, dim3(2048), dim3(256), 0, stream, (const bf16*)((char*)d_ws + WS_BR), DBG_BRSEL ? B_D : B_A, DBG_BRSEL ? B_D : B_B, (float*)d_out, (size_t)TL * D);
#endif
#endif
}
```
